# Optimizing an MI355X kernel written in HIP

```python
import jax
import jax.numpy as jnp
from jax import lax
import numpy as np


D_MODEL = 1024
BATCH = 8
SEQ = 4096
DEPTH = 4

CTX_LEN = 256
GRID_W = 64
N_MOD = 9
NORM_EPS = 1e-6
D_FF = 2816
ATTN_HEADS = 8
ATTN_KV_HEADS = 2
ATTN_GROUP = ATTN_HEADS // ATTN_KV_HEADS
ATTN_HEAD_DIM = 128
WINDOW = 128
ATTN_BLOCK = 128
ROPE_THETA = 10000.0
GLA_HEADS = 4
GLA_KEY_DIM = 128
GLA_VALUE_DIM = 256
GLA_GATE_RANK = 16
GLA_GATE_TEMP = 16.0
GLA_CHUNK = 64
ATTN_Q_W = ATTN_HEADS * ATTN_HEAD_DIM
ATTN_KV_W = ATTN_KV_HEADS * ATTN_HEAD_DIM
GLA_K_W = GLA_HEADS * GLA_KEY_DIM
GLA_V_W = GLA_HEADS * GLA_VALUE_DIM
CTX_SIDE_COLS = (ATTN_KV_W, ATTN_KV_W, GLA_K_W, GLA_V_W, GLA_GATE_RANK, GLA_GATE_RANK)
QUERY_SIDE_COLS = (ATTN_Q_W, GLA_K_W, GLA_V_W, D_MODEL, D_MODEL)
N_CTX_SIDE = sum(CTX_SIDE_COLS)
IN_COLS = N_CTX_SIDE + sum(QUERY_SIDE_COLS)

kernel_name = 'hybrid_flow_backbone_block'


def split_cols(z, sizes):
    idx = [int(i) for i in np.cumsum(sizes)[:-1]]
    return jnp.split(z, idx, axis=-1)


def flip_time(t):
    return jnp.flip(t, axis=1)


def rmsnorm(x, w):
    x32 = x.astype(jnp.float32)
    y = x32 * lax.rsqrt(jnp.mean(x32 * x32, axis=-1, keepdims=True) + NORM_EPS)
    return (y * w.astype(jnp.float32)).astype(x.dtype)


def adaln(cond, w, b):
    m = (cond @ w + b)[..., None, :]
    return jnp.split(m, N_MOD, axis=-1)


def modulate(h, shift, scale):
    return h * (1 + scale) + shift


def swiglu(h, w13, w2):
    up, gate = jnp.split(h @ w13, 2, axis=-1)
    return (jax.nn.silu(gate) * up) @ w2


def axial_rope_tables(n_tokens):
    rows = n_tokens // GRID_W
    row = jnp.repeat(jnp.arange(rows), GRID_W).astype(jnp.float32)
    col = jnp.tile(jnp.arange(GRID_W), rows).astype(jnp.float32)
    half = ATTN_HEAD_DIM // 2
    inv_freq = ROPE_THETA ** (-jnp.arange(0, half, 2, dtype=jnp.float32) / half)
    ang_r = row[:, None] * inv_freq[None, :]
    ang_c = col[:, None] * inv_freq[None, :]
    return (jnp.cos(ang_r), jnp.sin(ang_r), jnp.cos(ang_c), jnp.sin(ang_c))


def rotate_pairs(x, cos, sin):
    x1, x2 = jnp.split(x.astype(jnp.float32), 2, axis=-1)
    cos = cos[:, None, :]
    sin = sin[:, None, :]
    return jnp.concatenate([x1 * cos - x2 * sin, x1 * sin + x2 * cos], axis=-1)


def axial_rope(x, tabs):
    cos_r, sin_r, cos_c, sin_c = tabs
    x_row, x_col = jnp.split(x, 2, axis=-1)
    return jnp.concatenate([rotate_pairs(x_row, cos_r, sin_r), rotate_pairs(x_col, cos_c, sin_c)], axis=-1).astype(x.dtype)


def window_attention(q, k, v, kc, vc, sink):
    B, S = q.shape[:2]
    L = kc.shape[1]
    nb = S // ATTN_BLOCK
    scale = ATTN_HEAD_DIM ** -0.5
    qb = q.reshape(B, nb, ATTN_BLOCK, ATTN_KV_HEADS, ATTN_GROUP, ATTN_HEAD_DIM)

    def band(t):
        tp = jnp.pad(t, ((0, 0), (ATTN_BLOCK, ATTN_BLOCK), (0, 0), (0, 0)))
        tp = tp.reshape(B, nb + 2, ATTN_BLOCK, ATTN_KV_HEADS, ATTN_HEAD_DIM)
        return jnp.concatenate([tp[:, :-2], tp[:, 1:-1], tp[:, 2:]], axis=2)

    kw, vw = band(k), band(v)
    qi = jnp.arange(ATTN_BLOCK)[:, None]
    kj = jnp.arange(3 * ATTN_BLOCK)[None, :] - ATTN_BLOCK
    key_pos = jnp.arange(nb)[:, None, None] * ATTN_BLOCK + kj[None]
    mask = (jnp.abs(kj - qi) <= WINDOW)[None] & (key_pos >= 0) & (key_pos < S)
    s_win = jnp.einsum('bnqhgd,bnkhd->bnhgqk', qb, kw).astype(jnp.float32) * scale
    s_win = jnp.where(mask[None, :, None, None], s_win, -jnp.inf)
    s_ctx = jnp.einsum('bnqhgd,blhd->bnhgql', qb, kc).astype(jnp.float32) * scale
    s_sink = jnp.broadcast_to(sink.reshape(ATTN_KV_HEADS, ATTN_GROUP, 1, 1).astype(jnp.float32), s_ctx.shape[:-1] + (1,))
    p = jax.nn.softmax(jnp.concatenate([s_win, s_ctx, s_sink], axis=-1), axis=-1).astype(v.dtype)
    p_win = p[..., :3 * ATTN_BLOCK]
    p_ctx = p[..., 3 * ATTN_BLOCK:3 * ATTN_BLOCK + L]
    o = jnp.einsum('bnhgqk,bnkhd->bnqhgd', p_win, vw) + jnp.einsum('bnhgql,blhd->bnqhgd', p_ctx, vc)
    return o.reshape(B, S, ATTN_Q_W)


def context_attention(qc, kc, vc, sink):
    B, L = qc.shape[:2]
    scale = ATTN_HEAD_DIM ** -0.5
    qg = qc.reshape(B, L, ATTN_KV_HEADS, ATTN_GROUP, ATTN_HEAD_DIM)
    s = jnp.einsum('blhgd,bmhd->bhglm', qg, kc).astype(jnp.float32) * scale
    s_sink = jnp.broadcast_to(sink.reshape(ATTN_KV_HEADS, ATTN_GROUP, 1, 1).astype(jnp.float32), s.shape[:-1] + (1,))
    p = jax.nn.softmax(jnp.concatenate([s, s_sink], axis=-1), axis=-1).astype(vc.dtype)
    o = jnp.einsum('bhglm,bmhd->blhgd', p[..., :L], vc)
    return o.reshape(B, L, ATTN_Q_W)


def gla_log_decay(lowrank, w, b):
    B, T = lowrank.shape[:2]
    logit = (lowrank @ w + b).astype(jnp.float32)
    return (jax.nn.log_sigmoid(logit) / GLA_GATE_TEMP).reshape(B, T, GLA_HEADS, GLA_KEY_DIM)


def gla_chunk_scan(q, k, v, g, s0):
    B, T, H, dk = q.shape
    dv = v.shape[-1]
    nc = T // GLA_CHUNK
    out_dtype = v.dtype

    def chunks(t):
        return jnp.moveaxis(t.astype(jnp.float32).reshape(B, nc, GLA_CHUNK, H, t.shape[-1]), 1, 0)

    causal = jnp.tril(jnp.ones((GLA_CHUNK, GLA_CHUNK), dtype=bool))

    def step(s, inp):
        qc, kc, vc, gc = inp
        b = jnp.cumsum(gc, axis=1)
        o_inter = jnp.einsum('bchd,bhde->bche', qc * jnp.exp(b), s)
        diff = b[:, :, None] - b[:, None, :]
        decay = jnp.exp(jnp.where(causal[None, :, :, None, None], diff, -jnp.inf))
        a = jnp.einsum('bijhd,bjhd->bhij', qc[:, :, None] * decay, kc)
        o_intra = jnp.einsum('bhij,bjhe->bihe', a, vc)
        b_last = b[:, -1]
        s_new = jnp.exp(b_last)[..., None] * s + jnp.einsum('bchd,bche->bhde', kc * jnp.exp(b_last[:, None] - b), vc)
        return s_new, o_inter + o_intra

    s_final, o = lax.scan(step, s0.astype(jnp.float32), (chunks(q), chunks(k), chunks(v), chunks(g)))
    o = jnp.moveaxis(o, 0, 1).reshape(B, T, H, dv).astype(out_dtype)
    return o, s_final


def gla_final_state(k, v, g):
    k = k.astype(jnp.float32)
    v = v.astype(jnp.float32)
    b = jnp.cumsum(g.astype(jnp.float32), axis=1)
    w = jnp.exp(b[:, -1:] - b)
    return jnp.einsum('bthd,bthe->bhde', k * w, v)


def gla_output(o, r, w):
    B, T = r.shape[:2]
    return rmsnorm(o, w).reshape(B, T, GLA_V_W) * jax.nn.silu(r)


def merge_branches(y_attn, y_gla, gate_a, gate_g, w_ba, w_bg, w_out):
    return (jax.nn.sigmoid(gate_a) * (y_attn @ w_ba) + jax.nn.sigmoid(gate_g) * (y_gla @ w_bg)) @ w_out


def mixer(h, hc, w_in, q_norm_w, k_norm_w, sink, gw_f, gb_f, gw_b, gb_b, gla_norm_w, w_ba, w_bg, w_out, tabs, need_ctx_out):
    B, S, _ = h.shape
    L = hc.shape[1]
    ak, av, gk, gv, glr_f, glr_b, aq, gq, gr, gate_a, gate_g = split_cols(h @ w_in, CTX_SIDE_COLS + QUERY_SIDE_COLS)
    akc, avc, gkc, gvc, glrc_f, glrc_b = split_cols(hc @ w_in[:, :N_CTX_SIDE], CTX_SIDE_COLS)

    q = axial_rope(rmsnorm(aq.reshape(B, S, ATTN_HEADS, ATTN_HEAD_DIM), q_norm_w), tabs)
    k = axial_rope(rmsnorm(ak.reshape(B, S, ATTN_KV_HEADS, ATTN_HEAD_DIM), k_norm_w), tabs)
    v = av.reshape(B, S, ATTN_KV_HEADS, ATTN_HEAD_DIM)
    kc = rmsnorm(akc.reshape(B, L, ATTN_KV_HEADS, ATTN_HEAD_DIM), k_norm_w)
    vc = avc.reshape(B, L, ATTN_KV_HEADS, ATTN_HEAD_DIM)
    y_attn = window_attention(q, k, v, kc, vc, sink)

    gla_scale = GLA_KEY_DIM ** -0.5
    qg = gq.reshape(B, S, GLA_HEADS, GLA_KEY_DIM) * gla_scale
    kg = gk.reshape(B, S, GLA_HEADS, GLA_KEY_DIM)
    vg = gv.reshape(B, S, GLA_HEADS, GLA_VALUE_DIM)
    g_f = gla_log_decay(glr_f, gw_f, gb_f)
    g_b = gla_log_decay(glr_b, gw_b, gb_b)
    kgc = gkc.reshape(B, L, GLA_HEADS, GLA_KEY_DIM)
    vgc = gvc.reshape(B, L, GLA_HEADS, GLA_VALUE_DIM)
    gc_f = gla_log_decay(glrc_f, gw_f, gb_f)
    gc_b = gla_log_decay(glrc_b, gw_b, gb_b)

    if need_ctx_out:
        aqc, gqc, grc, gate_ac, gate_gc = split_cols(hc @ w_in[:, N_CTX_SIDE:], QUERY_SIDE_COLS)
        qc = rmsnorm(aqc.reshape(B, L, ATTN_HEADS, ATTN_HEAD_DIM), q_norm_w)
        yc_attn = context_attention(qc, kc, vc, sink)
        qgc = gqc.reshape(B, L, GLA_HEADS, GLA_KEY_DIM) * gla_scale
        zero = jnp.zeros((B, GLA_HEADS, GLA_KEY_DIM, GLA_VALUE_DIM), jnp.float32)
        oc_f, s_f = gla_chunk_scan(qgc, kgc, vgc, gc_f, zero)
        oc_b, s_b = gla_chunk_scan(flip_time(qgc), flip_time(kgc), flip_time(vgc), flip_time(gc_b), zero)
        yc_gla = gla_output(oc_f + flip_time(oc_b), grc, gla_norm_w)
        yc = merge_branches(yc_attn, yc_gla, gate_ac, gate_gc, w_ba, w_bg, w_out)
    else:
        s_f = gla_final_state(kgc, vgc, gc_f)
        s_b = gla_final_state(flip_time(kgc), flip_time(vgc), flip_time(gc_b))
        yc = None

    o_f, _ = gla_chunk_scan(qg, kg, vg, g_f, s_f)
    o_b, _ = gla_chunk_scan(flip_time(qg), flip_time(kg), flip_time(vg), flip_time(g_b), s_b)
    y_gla = gla_output(o_f + flip_time(o_b), gr, gla_norm_w)
    y = merge_branches(y_attn, y_gla, gate_a, gate_g, w_ba, w_bg, w_out)
    return y, yc


def setup_inputs(seed: int = 0) -> dict:
    key = jax.random.key(seed)
    ks = jax.random.split(key, 24)
    f32 = jnp.float32

    def nrm(k, shape, scale):
        return jax.random.normal(k, shape, f32) * scale

    return {
        'x': nrm(ks[0], (BATCH, SEQ, D_MODEL), 1.0),
        'c': nrm(ks[1], (BATCH, D_MODEL), 1.0),
        'ctx': nrm(ks[2], (BATCH, CTX_LEN, D_MODEL), 1.0),
        'c_ctx': nrm(ks[3], (D_MODEL,), 1.0),
        'w_mod': nrm(ks[4], (DEPTH, D_MODEL, N_MOD * D_MODEL), 0.5 * D_MODEL ** -0.5),
        'b_mod': nrm(ks[5], (DEPTH, N_MOD * D_MODEL), 0.02),
        'norm_w': 1.0 + nrm(ks[6], (DEPTH, 3, D_MODEL), 0.02),
        'ffn1_w13': nrm(ks[7], (DEPTH, D_MODEL, 2 * D_FF), D_MODEL ** -0.5),
        'ffn1_w2': nrm(ks[8], (DEPTH, D_FF, D_MODEL), D_FF ** -0.5),
        'ffn2_w13': nrm(ks[9], (DEPTH, D_MODEL, 2 * D_FF), D_MODEL ** -0.5),
        'ffn2_w2': nrm(ks[10], (DEPTH, D_FF, D_MODEL), D_FF ** -0.5),
        'w_in': nrm(ks[11], (DEPTH, D_MODEL, IN_COLS), D_MODEL ** -0.5),
        'q_norm_w': 1.0 + nrm(ks[12], (DEPTH, ATTN_HEAD_DIM), 0.02),
        'k_norm_w': 1.0 + nrm(ks[13], (DEPTH, ATTN_HEAD_DIM), 0.02),
        'attn_sink': nrm(ks[14], (DEPTH, ATTN_HEADS), 0.5),
        'gla_gate_w_fwd': nrm(ks[15], (DEPTH, GLA_GATE_RANK, GLA_K_W), GLA_GATE_RANK ** -0.5),
        'gla_gate_b_fwd': nrm(ks[16], (DEPTH, GLA_K_W), 0.1),
        'gla_gate_w_bwd': nrm(ks[17], (DEPTH, GLA_GATE_RANK, GLA_K_W), GLA_GATE_RANK ** -0.5),
        'gla_gate_b_bwd': nrm(ks[18], (DEPTH, GLA_K_W), 0.1),
        'gla_norm_w': 1.0 + nrm(ks[19], (DEPTH, GLA_VALUE_DIM), 0.02),
        'w_branch_attn': nrm(ks[20], (DEPTH, ATTN_Q_W, D_MODEL), ATTN_Q_W ** -0.5),
        'w_branch_gla': nrm(ks[21], (DEPTH, GLA_V_W, D_MODEL), GLA_V_W ** -0.5),
        'w_out': nrm(ks[22], (DEPTH, D_MODEL, D_MODEL), D_MODEL ** -0.5),
    }


def reference(x, c, ctx, c_ctx, w_mod, b_mod, norm_w, ffn1_w13, ffn1_w2, ffn2_w13, ffn2_w2, w_in, q_norm_w, k_norm_w, attn_sink, gla_gate_w_fwd, gla_gate_b_fwd, gla_gate_w_bwd, gla_gate_b_bwd, gla_norm_w, w_branch_attn, w_branch_gla, w_out):
    tabs = axial_rope_tables(x.shape[1])
    cond = jax.nn.silu(c)
    cond_ctx = jax.nn.silu(c_ctx)
    xc = ctx
    for l in range(DEPTH):
        last = l == DEPTH - 1
        m = adaln(cond, w_mod[l], b_mod[l])
        mc = adaln(cond_ctx, w_mod[l], b_mod[l])
        x = x + 0.5 * m[2] * swiglu(modulate(rmsnorm(x, norm_w[l, 0]), m[0], m[1]), ffn1_w13[l], ffn1_w2[l])
        xc = xc + 0.5 * mc[2] * swiglu(modulate(rmsnorm(xc, norm_w[l, 0]), mc[0], mc[1]), ffn1_w13[l], ffn1_w2[l])
        h = modulate(rmsnorm(x, norm_w[l, 1]), m[3], m[4])
        hc = modulate(rmsnorm(xc, norm_w[l, 1]), mc[3], mc[4])
        y, yc = mixer(h, hc, w_in[l], q_norm_w[l], k_norm_w[l], attn_sink[l],
                      gla_gate_w_fwd[l], gla_gate_b_fwd[l], gla_gate_w_bwd[l], gla_gate_b_bwd[l],
                      gla_norm_w[l], w_branch_attn[l], w_branch_gla[l], w_out[l], tabs, not last)
        x = x + m[5] * y
        x = x + 0.5 * m[8] * swiglu(modulate(rmsnorm(x, norm_w[l, 2]), m[6], m[7]), ffn2_w13[l], ffn2_w2[l])
        if not last:
            xc = xc + mc[5] * yc
            xc = xc + 0.5 * mc[8] * swiglu(modulate(rmsnorm(xc, norm_w[l, 2]), mc[6], mc[7]), ffn2_w13[l], ffn2_w2[l])
    return x
```

```cpp
#include <hip/hip_runtime.h>
#include <hip/hip_cooperative_groups.h>
#include <cstdio>
#include <cstdint>
namespace cg = cooperative_groups;

#define LAS __attribute__((address_space(3)))
typedef _Float16 f16;
typedef _Float16 f16x8 __attribute__((ext_vector_type(8)));
typedef _Float16 f16x4 __attribute__((ext_vector_type(4)));
typedef _Float16 f16x2 __attribute__((ext_vector_type(2)));
typedef short s16x8 __attribute__((ext_vector_type(8)));
typedef float f32x2 __attribute__((ext_vector_type(2)));
typedef float f32x4 __attribute__((ext_vector_type(4)));
typedef float f32x16 __attribute__((ext_vector_type(16)));
typedef unsigned u32x2 __attribute__((ext_vector_type(2)));
typedef unsigned u32x4 __attribute__((ext_vector_type(4)));

constexpr int DM = 1024, NB = 8, SEQ = 4096, DEPTH = 4, CTXL = 256, DFF = 2816;
constexpr int TL = NB * SEQ, TC = NB * CTXL, TT = TL + TC;
constexpr int NMOD = 9 * DM;
constexpr int INC = 6688;
constexpr int ZLD = 6656;
constexpr int Z_AK = 0, Z_AV = 256, Z_GK = 512, Z_GV = 1024, Z_AQ = 2048, Z_GQ = 3072, Z_GR = 3584, Z_GA = 4608, Z_GG = 5632;
constexpr int NIN = 6912;
constexpr int NTHR = 512;
constexpr int LDS_BYTES = 148480;

constexpr size_t WS_MOD = 0;
constexpr size_t WS_ROPE = WS_MOD + (size_t)DEPTH * 9 * NMOD * 4;
constexpr size_t WS_WA = WS_ROPE + 64 * 32 * 2 * 4;
constexpr size_t WA_W2 = (size_t)2 * DFF * DM * 2;
constexpr size_t WS_WB = WS_WA + WA_W2 + (size_t)DM * DFF * 2;
constexpr size_t WB_BA = (size_t)NIN * DM * 2, WB_BG = WB_BA + (size_t)DM * DM * 2, WB_OUT = WB_BG + (size_t)DM * DM * 2;
constexpr size_t WS_XH = WS_WB + WB_OUT + (size_t)DM * DM * 2;
constexpr size_t WS_H16 = WS_XH + (size_t)TT * DM * 2;
constexpr size_t WS_OB = WS_H16 + (size_t)TT * DM * 2;
constexpr size_t WS_GLR = WS_OB + (size_t)TT * DM * 2;
constexpr size_t WS_Z = WS_GLR + (size_t)TT * 32 * 4;
constexpr size_t WS_BAR = WS_Z + (size_t)TT * ZLD * 2;
constexpr size_t WS_END = WS_BAR + 16384;

struct Params {
    const float* in[23];
    float* out;
    unsigned char* ws;
};

__device__ __forceinline__ unsigned pk_f16(float a, float b) { f16x2 v; v.x = (f16)a; v.y = (f16)b; return __builtin_bit_cast(unsigned, v); }
typedef __bf16 bf16x2_t __attribute__((ext_vector_type(2)));
__device__ __forceinline__ unsigned pk_bf16(float lo, float hi) { f32x2 v; v.x = lo; v.y = hi; const bf16x2_t b = __builtin_convertvector(v, bf16x2_t); return __builtin_bit_cast(unsigned, b); }
__device__ __forceinline__ float sigmoidf_(float x) { return __builtin_amdgcn_rcpf(1.0f + __builtin_amdgcn_exp2f(x * -1.4426950408889634f)); }
__device__ __forceinline__ float wave_sum(float v) {
#pragma unroll
    for (int o = 32; o >= 1; o >>= 1) v += __shfl_xor(v, o);
    return v;
}

namespace pg8 {
constexpr int BM = 256, BK = 64, HALF = 128, HTB = HALF * BK * 2, STAGE_BYTES = 8 * HTB, NXCD = 8, WGM = 8;
__host__ __device__ __forceinline__ int lds_byte(int r, int c) { const int st = (r >> 4) * 2 + (c >> 5), rr = r & 15, cc = c & 31, ob = rr * 64 + cc * 2; return st * 1024 + (ob ^ (((ob >> 9) & 1) << 5)); }
__host__ __device__ __forceinline__ void stage_rc(int b, int& R, int& C) { const int st = b / 1024, sb = b % 1024, swz = sb ^ (((sb >> 9) & 1) << 5); R = (st >> 1) * 16 + swz / 64; C = (st & 1) * 32 + (swz % 64) / 2; }
__host__ __device__ __forceinline__ int perm32(int rho) { const int n = rho >> 4, i = rho & 15; return 8 * (i >> 2) + 4 * n + (i & 3); }
struct Unit { int pm, pn, roff, half; };
struct Gemm { const f16* A; const f16* Bt; int M, N, K, lda, ldb; };
struct StaticOrder {
    int nM, nN, nwg, G, c, nhalf;
    __device__ void init(int M, int N, int G_, int c_) { nM = M / BM; nN = N / BM; nwg = nM * nN; G = G_; c = c_; nhalf = 0; }
    __device__ void init_tail(int Mfull, int M, int N, int G_, int c_) { nM = Mfull / BM; nN = N / BM; nwg = nM * nN; G = G_; c = c_; nhalf = ((M - Mfull) / HALF) * nN; }
    __device__ bool next(int i, Unit& u) const {
        const long L = (long)i * G + c; if (L >= nwg + nhalf) return false;
        if (L >= nwg) { const int hx = (int)L - nwg, hp = hx / nN; u.pn = hx % nN; u.pm = nM + (hp >> 1); u.roff = (hp & 1) * HALF; u.half = 1; return true; }
        int wgid = (int)L; { const int q = nwg / NXCD, r = nwg % NXCD, xcd = wgid % NXCD, off = wgid / NXCD; wgid = (xcd < r ? xcd * (q + 1) : r * (q + 1) + (xcd - r) * q) + off; }
        const int nig = WGM * nN, gid = wgid / nig, fm = gid * WGM, gsz = (nM - fm) < WGM ? (nM - fm) : WGM;
        u.pm = fm + ((wgid % nig) % gsz); u.pn = (wgid % nig) / gsz; u.roff = 0; u.half = 0; return true;
    }
};

#ifndef PG8_SP2
#define PG8_SP2 true
#endif
#ifndef PG8_ALIGN
#define PG8_ALIGN true
#endif
template <bool BF16> __device__ __forceinline__ f32x4 mma16_(f16x8 b, f16x8 a, f32x4 c) {
    if constexpr (BF16) return __builtin_amdgcn_mfma_f32_16x16x32_bf16(__builtin_bit_cast(s16x8, b), __builtin_bit_cast(s16x8, a), c, 0, 0, 0);
    else return __builtin_amdgcn_mfma_f32_16x16x32_f16(b, a, c, 0, 0, 0);
}
template <class Epi, bool ALIGN_EPI = PG8_ALIGN, bool SP2 = PG8_SP2>
__device__ __forceinline__ void gemm_phase(LAS unsigned char* lds, const Gemm g, const StaticOrder& S, const Epi& E, unsigned* arrive_word = nullptr, int arrive_after = 0) {
    int tid_ = threadIdx.x; asm volatile("" : "+v"(tid_));
    const int tid = tid_, wid = __builtin_amdgcn_readfirstlane(tid >> 6), lane = tid & 63, wr = wid >> 2, wc = wid & 3, fr = lane & 15, fq = lane >> 4;
    const int K = g.K, nt = K / BK;
    unsigned voffA[2], voffB[2];
#pragma unroll
    for (int i = 0; i < 2; ++i) { int R, C; stage_rc(tid * 16 + i * 8192, R, C); const int Rb = Epi::PERM ? ((R & ~31) + perm32(R & 31)) : R;
        voffA[i] = (unsigned)(R * g.lda + C) * 2u; voffB[i] = (unsigned)(Rb * g.ldb + C) * 2u; }
    const size_t kstep = (size_t)(BK * 2);
    const size_t hA = (size_t)HALF * g.lda * 2, hB = (size_t)HALF * g.ldb * 2;
    const size_t tA = 2 * hA, tB = 2 * hB;
    const unsigned ldsw = (unsigned)wid * 1024u;
    const int aoff = lds_byte(wr * 64 + fr, fq * 8), boff = lds_byte(wc * 32 + fr, fq * 8);
#define PG8_SA(b, h) (((b) * 2 + (h)) * HTB)
#define PG8_SB(b, h) ((4 + (b) * 2 + (h)) * HTB)
#define PG8_STAGE(bufoff, gbase, voff) do { _Pragma("unroll") for (int _i = 0; _i < 2; ++_i) \
        __builtin_amdgcn_global_load_lds((const unsigned*)((const char*)(gbase) + (voff)[_i]), (LAS unsigned*)(lds + (bufoff) + ldsw + _i * 8192), 16, 0, 0); } while (0)
#define PG8_LDA(dst, b, h) do { _Pragma("unroll") for (int m = 0; m < 4; ++m) _Pragma("unroll") for (int k = 0; k < 2; ++k) dst[m][k] = *(const LAS f16x8*)(lds + PG8_SA(b, h) + aoff + m * 2048 + k * 1024); } while (0)
#define PG8_LDB(dst, b, h) do { _Pragma("unroll") for (int n = 0; n < 2; ++n) _Pragma("unroll") for (int k = 0; k < 2; ++k) dst[n][k] = *(const LAS f16x8*)(lds + PG8_SB(b, h) + boff + n * 2048 + k * 1024); } while (0)
#define PG8_MMA(ai, bj, At, Bt) do { __builtin_amdgcn_s_setprio(1); _Pragma("unroll") for (int m = 0; m < 4; ++m) _Pragma("unroll") for (int n = 0; n < 2; ++n) _Pragma("unroll") for (int k = 0; k < 2; ++k) \
        acc[ai][bj][m][n] = mma16_<Epi::BF16>(Bt[n][k], At[m][k], acc[ai][bj][m][n]); __builtin_amdgcn_s_setprio(0); } while (0)
#define PG8_WAIT_V(n) asm volatile("s_waitcnt vmcnt(" #n ")" ::: "memory")
#define PG8_WAIT_L(n) asm volatile("s_waitcnt lgkmcnt(" #n ")" ::: "memory")
#define PG8_BAR __builtin_amdgcn_s_barrier()
#define PG8_SCHED __builtin_amdgcn_sched_barrier(0)
    Unit cur, nxt; int ui = 0;
    if (!S.next(0, cur)) return;
    f32x4 acc[2][2][4][2];
#pragma unroll
    for (int a = 0; a < 2; ++a)
#pragma unroll
        for (int b = 0; b < 2; ++b)
#pragma unroll
            for (int m = 0; m < 4; ++m)
#pragma unroll
                for (int n = 0; n < 2; ++n) acc[a][b][m][n] = (f32x4){0.f, 0.f, 0.f, 0.f};
    f16x8 At[4][2], B0[2][2], B1[2][2];
    const char* cA = (const char*)g.A + (size_t)cur.pm * tA + (cur.roff ? hA : (size_t)0); const char* cB = (const char*)g.Bt + (size_t)cur.pn * tB;
    if constexpr (SP2) {
        PG8_STAGE(PG8_SB(0, 0), cB, voffB); PG8_STAGE(PG8_SB(0, 1), cB + hB, voffB); PG8_STAGE(PG8_SA(0, 0), cA, voffA); PG8_STAGE(PG8_SA(0, 1), cA + hA, voffA);
        if (wr == 1) PG8_BAR;
        PG8_WAIT_V(2); PG8_BAR;
        PG8_STAGE(PG8_SB(1, 0), cB + kstep, voffB); PG8_STAGE(PG8_SA(1, 0), cA + kstep, voffA); PG8_STAGE(PG8_SB(1, 1), cB + hB + kstep, voffB);
        PG8_WAIT_V(6); PG8_BAR;
    } else {
        PG8_STAGE(PG8_SB(0, 0), cB, voffB); PG8_STAGE(PG8_SA(0, 0), cA, voffA); PG8_STAGE(PG8_SB(0, 1), cB + hB, voffB); PG8_STAGE(PG8_SA(0, 1), cA + hA, voffA);
        if (wr == 1) PG8_BAR;
        PG8_WAIT_V(4); PG8_BAR;
        PG8_STAGE(PG8_SB(1, 0), cB + kstep, voffB); PG8_STAGE(PG8_SA(1, 0), cA + kstep, voffA); PG8_STAGE(PG8_SB(1, 1), cB + hB + kstep, voffB);
        PG8_WAIT_V(6); PG8_BAR;
    }
    for (;;) {
        const bool has_next = S.next(ui + 1, nxt);
        const char* nA = has_next ? (const char*)g.A + (size_t)nxt.pm * tA + (nxt.roff ? hA : (size_t)0) : cA; const char* nB = has_next ? (const char*)g.Bt + (size_t)nxt.pn * tB : cB;
        for (int t = 0; t < nt; t += 2) {
            const bool last = (t == nt - 2);
            const char* a1 = cA + (size_t)(t + 1) * kstep;
            const char* a2 = last ? nA : cA + (size_t)(t + 2) * kstep; const char* b2 = last ? nB : cB + (size_t)(t + 2) * kstep;
            const char* a3 = a2 + kstep; const char* b3 = b2 + kstep;
            if constexpr (SP2) {
            PG8_LDB(B0, 0, 0); PG8_LDB(B1, 0, 1); PG8_SCHED; PG8_LDA(At, 0, 0); PG8_STAGE(PG8_SA(1, 1), a1 + hA, voffA);
            PG8_WAIT_V(8); PG8_WAIT_L(0); PG8_BAR; PG8_MMA(0, 0, At, B0); PG8_MMA(0, 1, At, B1); PG8_BAR; PG8_SCHED;
            PG8_LDA(At, 0, 1); PG8_STAGE(PG8_SB(0, 0), b2, voffB); PG8_STAGE(PG8_SB(0, 1), b2 + hB, voffB); PG8_STAGE(PG8_SA(0, 0), a2, voffA);
            PG8_WAIT_V(8); PG8_WAIT_L(0); PG8_BAR; if (!cur.half) { PG8_MMA(1, 0, At, B0); PG8_MMA(1, 1, At, B1); } PG8_BAR; PG8_SCHED;
            PG8_LDB(B0, 1, 0); PG8_LDB(B1, 1, 1); PG8_SCHED; PG8_LDA(At, 1, 0); PG8_STAGE(PG8_SA(0, 1), a2 + hA, voffA);
            PG8_WAIT_V(8); PG8_WAIT_L(0); PG8_BAR; PG8_MMA(0, 0, At, B0); PG8_MMA(0, 1, At, B1); PG8_BAR; PG8_SCHED;
            PG8_LDA(At, 1, 1); PG8_STAGE(PG8_SB(1, 0), b3, voffB); PG8_STAGE(PG8_SB(1, 1), b3 + hB, voffB); PG8_STAGE(PG8_SA(1, 0), a3, voffA);
            PG8_WAIT_V(8); PG8_WAIT_L(0); PG8_BAR; if (!cur.half) { PG8_MMA(1, 0, At, B0); PG8_MMA(1, 1, At, B1); } PG8_BAR; PG8_SCHED;
            } else {
            PG8_LDB(B0, 0, 0); PG8_SCHED; PG8_LDA(At, 0, 0); PG8_STAGE(PG8_SA(1, 1), a1 + hA, voffA);
            PG8_WAIT_L(8); PG8_BAR; PG8_WAIT_L(0); PG8_MMA(0, 0, At, B0); PG8_BAR; PG8_SCHED;
            PG8_LDB(B1, 0, 1); PG8_STAGE(PG8_SB(0, 0), b2, voffB);
            PG8_BAR; PG8_WAIT_L(0); PG8_MMA(0, 1, At, B1); PG8_BAR;
            PG8_LDA(At, 0, 1); PG8_STAGE(PG8_SA(0, 0), a2, voffA);
            PG8_BAR; PG8_WAIT_L(0); if (!cur.half) PG8_MMA(1, 0, At, B0); PG8_BAR; PG8_SCHED;
            PG8_STAGE(PG8_SB(0, 1), b2 + hB, voffB);
            PG8_WAIT_V(6); PG8_BAR; if (!cur.half) PG8_MMA(1, 1, At, B1); PG8_BAR;
            PG8_LDB(B0, 1, 0); PG8_SCHED; PG8_LDA(At, 1, 0); PG8_STAGE(PG8_SA(0, 1), a2 + hA, voffA);
            PG8_WAIT_L(8); PG8_BAR; PG8_WAIT_L(0); PG8_MMA(0, 0, At, B0); PG8_BAR; PG8_SCHED;
            PG8_LDB(B1, 1, 1); PG8_STAGE(PG8_SB(1, 0), b3, voffB);
            PG8_BAR; PG8_WAIT_L(0); PG8_MMA(0, 1, At, B1); PG8_BAR;
            PG8_LDA(At, 1, 1); PG8_STAGE(PG8_SA(1, 0), a3, voffA);
            PG8_BAR; PG8_WAIT_L(0); if (!cur.half) PG8_MMA(1, 0, At, B0); PG8_BAR; PG8_SCHED;
            PG8_STAGE(PG8_SB(1, 1), b3 + hB, voffB);
            PG8_WAIT_V(6); PG8_BAR; if (!cur.half) PG8_MMA(1, 1, At, B1); PG8_BAR;
            }
        }
        if constexpr (ALIGN_EPI) { if (wr == 0) PG8_BAR; }
        E(acc, cur, wr, wc, fr, fq);
        if (ALIGN_EPI && arrive_word && ui + 1 == arrive_after) {
            asm volatile("s_waitcnt vmcnt(0) lgkmcnt(0)" ::: "memory"); PG8_BAR;
            if (tid == 0) { __builtin_amdgcn_fence(__ATOMIC_RELEASE, "agent"); asm volatile("s_waitcnt vmcnt(0)" ::: "memory");
                (void)__hip_atomic_fetch_add(arrive_word, 1u, __ATOMIC_RELAXED, __HIP_MEMORY_SCOPE_AGENT); } }
        if (!has_next) break;
#pragma unroll
        for (int a = 0; a < 2; ++a)
#pragma unroll
            for (int b = 0; b < 2; ++b)
#pragma unroll
                for (int m = 0; m < 4; ++m)
#pragma unroll
                    for (int n = 0; n < 2; ++n) acc[a][b][m][n] = (f32x4){0.f, 0.f, 0.f, 0.f};
        cur = nxt; cA = nA; cB = nB; ++ui;
        if constexpr (ALIGN_EPI) { if (wr == 1) PG8_BAR; }
    }
    PG8_WAIT_V(0);
    if constexpr (!ALIGN_EPI) { if (wr == 0) PG8_BAR; }
    PG8_BAR;
#undef PG8_SA
#undef PG8_SB
#undef PG8_STAGE
#undef PG8_LDA
#undef PG8_LDB
#undef PG8_MMA
#undef PG8_WAIT_V
#undef PG8_WAIT_L
#undef PG8_BAR
#undef PG8_SCHED
}
}
using pg8::Unit;
using pg8::Gemm;

struct EpiSwiglu {
    static constexpr bool PERM = true, BF16 = true;
    f16* O;
    __device__ __forceinline__ void operator()(const f32x4 (&acc)[2][2][4][2], const Unit& u, int wr, int wc, int fr, int fq) const {
        const int row0 = u.pm * 256 + wr * 64 + fr, col0 = u.pn * 128 + wc * 32 + 8 * fq;
#pragma unroll
        for (int ai = 0; ai < 2; ++ai)
#pragma unroll
            for (int m = 0; m < 4; ++m) {
                float o[8];
#pragma unroll
                for (int n = 0; n < 2; ++n)
#pragma unroll
                    for (int j = 0; j < 4; ++j) { const float up = acc[ai][0][m][n][j], gt = acc[ai][1][m][n][j]; o[n * 4 + j] = up * gt * sigmoidf_(gt); }
                u32x4 w; w.x = pk_bf16(o[0], o[1]); w.y = pk_bf16(o[2], o[3]); w.z = pk_bf16(o[4], o[5]); w.w = pk_bf16(o[6], o[7]);
                *(u32x4*)(O + (size_t)(row0 + ai * 128 + m * 16) * DFF + col0) = w;
            }
    }
};
struct EpiResid {
    static constexpr bool PERM = true, BF16 = true;
    const float* xl_src; const float* xc_src; f16* XH; float* out32; const float* gate; float coef; bool SRC32, DST32;
    __device__ __forceinline__ void operator()(const f32x4 (&acc)[2][2][4][2], const Unit& u, int wr, int wc, int fr, int fq) const {
        const bool lat = u.pm < 128; const int mi = lat ? (u.pm >> 4) : 8;
        const size_t inrow = (size_t)(u.roff + wr * 64 + fr) * DM + u.pn * 256 + wc * 32 + 8 * fq;
        const size_t gofs = (size_t)u.pm * 256 * DM + inrow;
        const float* s32 = (lat ? xl_src : xc_src) + (size_t)(lat ? u.pm : u.pm - 128) * 256 * DM + inrow;
        const float* gp = gate + (size_t)mi * NMOD + u.pn * 256 + wc * 32 + 8 * fq;
#pragma unroll
        for (int bj = 0; bj < 2; ++bj) { const f32x4 g0 = *(const f32x4*)(gp + bj * 128) * coef, g1 = *(const f32x4*)(gp + bj * 128 + 4) * coef;
#pragma unroll
            for (int ai = 0; ai < 2; ++ai) { if (ai == 1 && u.half) break;
#pragma unroll
                for (int m = 0; m < 4; ++m) { const size_t ro = (size_t)(ai * 128 + m * 16) * DM + bj * 128;
                    f32x4 x0, x1;
                    if (SRC32) { x0 = *(const f32x4*)(s32 + ro); x1 = *(const f32x4*)(s32 + ro + 4); }
                    else { const f16x8 t = *(const f16x8*)(XH + gofs + ro); x0 = (f32x4){(float)t[0], (float)t[1], (float)t[2], (float)t[3]}; x1 = (f32x4){(float)t[4], (float)t[5], (float)t[6], (float)t[7]}; }
                    x0 += g0 * acc[ai][bj][m][0]; x1 += g1 * acc[ai][bj][m][1];
                    if (DST32) { *(f32x4*)(out32 + gofs + ro) = x0; *(f32x4*)(out32 + gofs + ro + 4) = x1; }
                    else { u32x4 w; w.x = pk_f16(x0[0], x0[1]); w.y = pk_f16(x0[2], x0[3]); w.z = pk_f16(x1[0], x1[1]); w.w = pk_f16(x1[2], x1[3]); *(u32x4*)(XH + gofs + ro) = w; } } } }
    }
};
struct EpiWin {
    static constexpr bool PERM = true, BF16 = true;
    f16* Z; float* GLR;
    __device__ __forceinline__ void operator()(const f32x4 (&acc)[2][2][4][2], const Unit& u, int wr, int wc, int fr, int fq) const {
        const int row0 = u.pm * 256 + wr * 64 + fr;
        if (u.pn < 26) {
            const int col0 = u.pn * 256 + wc * 32 + 8 * fq;
#pragma unroll
            for (int ai = 0; ai < 2; ++ai)
#pragma unroll
                for (int m = 0; m < 4; ++m) { f16* rowp = Z + (size_t)(row0 + ai * 128 + m * 16) * ZLD + col0;
#pragma unroll
                    for (int bj = 0; bj < 2; ++bj) { const f32x4 v0 = acc[ai][bj][m][0], v1 = acc[ai][bj][m][1];
                        u32x4 w; w.x = pk_f16(v0[0], v0[1]); w.y = pk_f16(v0[2], v0[3]); w.z = pk_f16(v1[0], v1[1]); w.w = pk_f16(v1[2], v1[3]);
                        *(u32x4*)(rowp + bj * 128) = w; } }
        } else if (wc == 0) {
#pragma unroll
            for (int ai = 0; ai < 2; ++ai)
#pragma unroll
                for (int m = 0; m < 4; ++m) { float* rowp = GLR + (size_t)(row0 + ai * 128 + m * 16) * 32 + 8 * fq;
                    *(f32x4*)(rowp) = acc[ai][0][m][0]; *(f32x4*)(rowp + 4) = acc[ai][0][m][1]; }
        }
    }
};
template <bool SECOND> struct EpiMerge {
    static constexpr bool PERM = true, BF16 = true;
    f16* M16; const f16* G;
    __device__ __forceinline__ void operator()(const f32x4 (&acc)[2][2][4][2], const Unit& u, int wr, int wc, int fr, int fq) const {
        const int row0 = u.pm * 256 + u.roff + wr * 64 + fr, col0 = u.pn * 256 + wc * 32 + 8 * fq;
#pragma unroll
        for (int ai = 0; ai < 2; ++ai) { if (ai == 1 && u.half) break;
#pragma unroll
            for (int m = 0; m < 4; ++m) { const size_t r = (size_t)(row0 + ai * 128 + m * 16);
#pragma unroll
                for (int bj = 0; bj < 2; ++bj) {
                    const f16x8 gt = *(const f16x8*)(G + r * ZLD + col0 + bj * 128);
                    f16* mp = M16 + r * DM + col0 + bj * 128;
                    float o[8];
#pragma unroll
                    for (int n = 0; n < 2; ++n)
#pragma unroll
                        for (int j = 0; j < 4; ++j) o[n * 4 + j] = sigmoidf_((float)gt[n * 4 + j]) * acc[ai][bj][m][n][j];
                    if (SECOND) { const u32x4 pv = *(const u32x4*)mp; const unsigned pw[4] = {pv.x, pv.y, pv.z, pv.w};
#pragma unroll
                        for (int e = 0; e < 4; ++e) { o[2 * e] += __uint_as_float(pw[e] << 16); o[2 * e + 1] += __uint_as_float(pw[e] & 0xffff0000u); } }
                    u32x4 w; w.x = pk_bf16(o[0], o[1]); w.y = pk_bf16(o[2], o[3]); w.z = pk_bf16(o[4], o[5]); w.w = pk_bf16(o[6], o[7]);
                    *(u32x4*)mp = w; } } }
    }
};

struct Frame {
    LAS unsigned char* lds; int tid, lane, wave, G, bid;
    const float* in[23]; float* out; unsigned char* ws;
    float* MOD; float* ROPE; f16* W13T; f16* W2T; f16* WINT; f16* WBAT; f16* WBGT; f16* WOUTT; f16* XH; f16* H16; f16* OB; float* GLR; f16* Z;
};

__device__ __forceinline__ void conv_weight(const Frame& F, const float* src, f16* dst, int K, int ld, int Nd, int mode, int ci, int nc) {
    LAS f16* tile = (LAS f16*)F.lds;
    const int nkt = K / 128, nitems = (Nd / 64) * nkt;
    for (int it = ci; it < nitems; it += nc) {
        const int nt = it / nkt, kt = it % nkt, n0 = nt * 64;
        int sc = n0, valid = 64;
        if (mode == 1) { const int pn = n0 >> 8, w = n0 & 255; sc = (w < 128) ? (pn * 128 + w) : (DFF + pn * 128 + w - 128); }
        else if (mode == 2) { if (n0 < 2048) sc = n0; else if (n0 < 6656) sc = n0 + 32; else if (n0 == 6656) { sc = 2048; valid = 32; } else { sc = 0; valid = 0; } }
        __syncthreads();
#pragma unroll
        for (int q = 0; q < 4; ++q) {
            const int idx = F.tid + q * NTHR, kr = idx >> 4, c4 = (idx & 15) * 4;
            f32x4 v = (f32x4){0.f, 0.f, 0.f, 0.f};
            if (c4 < valid) v = *(const f32x4*)(src + (size_t)(kt * 128 + kr) * ld + sc + c4);
#pragma unroll
            for (int e = 0; e < 4; ++e) { if (mode != 0) ((LAS unsigned short*)tile)[(c4 + e) * 136 + kr] = (unsigned short)(pk_bf16(v[e], v[e]) & 0xffffu); else tile[(c4 + e) * 136 + kr] = (f16)v[e]; }
        }
        __syncthreads();
#pragma unroll
        for (int q = 0; q < 2; ++q) {
            const int ch = F.tid + q * NTHR, n = ch >> 4, kc = (ch & 15) * 8;
            *(u32x4*)(dst + (size_t)(n0 + n) * K + kt * 128 + kc) = *(const LAS u32x4*)(tile + n * 136 + kc);
        }
    }
    __syncthreads();
}

__device__ __forceinline__ void phase_mod(const Frame& F) {
    LAS float* cond = (LAS float*)F.lds;
    LAS float* red = (LAS float*)(F.lds + 9 * 1024 * 4);
    for (int i = F.tid; i < 9 * 1024; i += NTHR) { const float v = (i < 8192) ? F.in[1][i] : F.in[3][i - 8192]; cond[i] = v * sigmoidf_(v); }
    __syncthreads();
    const int col = F.tid & 127, kq = F.tid >> 7;
    for (int it = F.bid; it < DEPTH * 72; it += F.G) {
        const int l = it / 72, n = (it % 72) * 128 + col;
        const float* wp = F.in[4] + (size_t)l * DM * NMOD + n;
        float a[9];
#pragma unroll
        for (int i = 0; i < 9; ++i) a[i] = 0.f;
#pragma unroll 16
        for (int k = kq * 256; k < kq * 256 + 256; ++k) { const float w = wp[(size_t)k * NMOD];
#pragma unroll
            for (int i = 0; i < 9; ++i) a[i] += cond[i * 1024 + k] * w; }
        __syncthreads();
#pragma unroll
        for (int i = 0; i < 9; ++i) red[(kq * 9 + i) * 128 + col] = a[i];
        __syncthreads();
        if (kq == 0) { const float bb = F.in[5][(size_t)l * NMOD + n];
#pragma unroll
            for (int i = 0; i < 9; ++i) F.MOD[((size_t)l * 9 + i) * NMOD + n] = red[i * 128 + col] + red[(9 + i) * 128 + col] + red[(18 + i) * 128 + col] + red[(27 + i) * 128 + col] + bb; }
    }
    const int gt = F.bid * NTHR + F.tid;
    if (gt < 2048) { const int pos = gt >> 5, i = gt & 31; const float inv = exp2f(-(float)i * (13.287712379549449f / 32.0f)); const float ang = (float)pos * inv;
        float rev = ang * 0.15915494309189535f; rev -= rintf(rev);
        const float r = rev * 6.283185307179586f;
        F.ROPE[gt * 2] = __cosf(r); F.ROPE[gt * 2 + 1] = __sinf(r); }
    __syncthreads();
}

__device__ __forceinline__ void phase_norm(const Frame& F, const float* xl, const float* xc, const f16* x16, int l, int which, int r0, int nrows, int ci, int nc) {
    const float* nw = F.in[6] + ((size_t)l * 3 + which) * DM;
    const int gw = r0 + ci * 8 + F.wave, nw_ = nc * 8;
    for (int row = gw; row < nrows; row += nw_) {
        const bool lat = row < TL; const int mi = lat ? (row >> 12) : 8;
        const float* sh = F.MOD + ((size_t)l * 9 + mi) * NMOD + (3 * which) * DM; const float* sc = sh + DM;
        float v[2][8]; float ss = 0.f;
        if (x16) {
            const f16* xp = x16 + (size_t)row * DM;
#pragma unroll
            for (int j = 0; j < 2; ++j) { const f16x8 t = *(const f16x8*)(xp + j * 512 + F.lane * 8);
#pragma unroll
                for (int e = 0; e < 8; ++e) v[j][e] = (float)t[e]; }
        } else {
            const float* xp = lat ? xl + (size_t)row * DM : xc + (size_t)(row - TL) * DM;
#pragma unroll
            for (int j = 0; j < 2; ++j) { const f32x4 a = *(const f32x4*)(xp + j * 512 + F.lane * 8), b = *(const f32x4*)(xp + j * 512 + F.lane * 8 + 4);
#pragma unroll
                for (int e = 0; e < 4; ++e) { v[j][e] = a[e]; v[j][4 + e] = b[e]; } }
        }
#pragma unroll
        for (int j = 0; j < 2; ++j)
#pragma unroll
            for (int e = 0; e < 8; ++e) ss += v[j][e] * v[j][e];
        ss = wave_sum(ss);
        const float rstd = rsqrtf(ss * (1.0f / DM) + 1e-6f);
#pragma unroll
        for (int j = 0; j < 2; ++j) { const int k = j * 512 + F.lane * 8;
            float o[8];
#pragma unroll
            for (int q = 0; q < 2; ++q) { const f32x4 w = *(const f32x4*)(nw + k + 4 * q), s1 = *(const f32x4*)(sc + k + 4 * q), s0 = *(const f32x4*)(sh + k + 4 * q);
#pragma unroll
                for (int e = 0; e < 4; ++e) o[4 * q + e] = v[j][4 * q + e] * rstd * w[e] * (1.0f + s1[e]) + s0[e]; }
            u32x4 pk;
            if (true) { pk.x = pk_bf16(o[0], o[1]); pk.y = pk_bf16(o[2], o[3]); pk.z = pk_bf16(o[4], o[5]); pk.w = pk_bf16(o[6], o[7]); }
            else { pk.x = pk_f16(o[0], o[1]); pk.y = pk_f16(o[2], o[3]); pk.z = pk_f16(o[4], o[5]); pk.w = pk_f16(o[6], o[7]); }
            *(u32x4*)(F.H16 + (size_t)row * DM + k) = pk; }
    }
}

__device__ __forceinline__ void phase_qkprep(const Frame& F, int l, bool last, int ci, int nc) {
    const float* qnw = F.in[12] + l * 128; const float* knw = F.in[13] + l * 128;
    const int lane = F.lane, j = lane & 7, hd = lane >> 3;
    const float QS = 0.08838834764831845f * 1.4426950408889634f;
    float wq[16], wk[16];
#pragma unroll
    for (int e = 0; e < 16; ++e) { wq[e] = qnw[j * 16 + e] * QS; wk[e] = knw[j * 16 + e]; }
    const bool second = (j & 2) != 0;
    const int gw = ci * 8 + F.wave, nw_ = nc * 8;
    for (int row = gw; row < TT; row += nw_) {
        const bool lat = row < TL;
        float cs[16], sn[16];
        if (lat) { const int t = row & 4095, pos = (j < 4) ? (t >> 6) : (t & 63); const float* tp = F.ROPE + (pos * 32 + (j & 1) * 16) * 2;
#pragma unroll
            for (int q4 = 0; q4 < 8; ++q4) { const f32x4 v = *(const f32x4*)(tp + q4 * 4); cs[q4 * 2] = v[0]; sn[q4 * 2] = v[1]; cs[q4 * 2 + 1] = v[2]; sn[q4 * 2 + 1] = v[3]; } }
        else {
#pragma unroll
            for (int e = 0; e < 16; ++e) { cs[e] = 1.f; sn[e] = 0.f; } }
        f16* zp = F.Z + (size_t)row * ZLD;
#pragma unroll
        for (int pass = 0; pass < 2; ++pass) {
            if (pass == 0 && !lat && last) continue;
            if (pass == 1 && hd >= 2) continue;
            f16* p = (pass == 0 ? zp + Z_AQ : zp + Z_AK) + hd * 128 + j * 16;
            const f16x8 r0 = *(const f16x8*)p, r1 = *(const f16x8*)(p + 8);
            float x[16]; float ss = 0.f;
#pragma unroll
            for (int e = 0; e < 8; ++e) { x[e] = (float)r0[e]; x[8 + e] = (float)r1[e]; }
#pragma unroll
            for (int e = 0; e < 16; ++e) ss += x[e] * x[e];
            ss += __shfl_xor(ss, 1); ss += __shfl_xor(ss, 2); ss += __shfl_xor(ss, 4);
            const float rstd = rsqrtf(ss * (1.0f / 128.0f) + 1e-6f);
            float o[16];
#pragma unroll
            for (int e = 0; e < 16; ++e) { const float xn = x[e] * rstd * (pass == 0 ? wq[e] : wk[e]); const float pn = __shfl_xor(xn, 2);
                o[e] = second ? (pn * sn[e] + xn * cs[e]) : (xn * cs[e] - pn * sn[e]); }
            u32x4 w0, w1; w0.x = pk_f16(o[0], o[1]); w0.y = pk_f16(o[2], o[3]); w0.z = pk_f16(o[4], o[5]); w0.w = pk_f16(o[6], o[7]);
            w1.x = pk_f16(o[8], o[9]); w1.y = pk_f16(o[10], o[11]); w1.z = pk_f16(o[12], o[13]); w1.w = pk_f16(o[14], o[15]);
            *(u32x4*)p = w0; *(u32x4*)(p + 8) = w1;
        }
    }
}

constexpr int GL_RQ = 0;
constexpr int GL_AM = GL_RQ;
constexpr int GL_RK = GL_RQ + 64 * 136 * 2;
constexpr int GL_LR = GL_RK + 64 * 136 * 2;
constexpr int GL_QT = GL_LR + 64 * 16 * 4;
constexpr int GL_KH = GL_QT + 64 * 136 * 2;
constexpr int GL_KT = GL_KH + 64 * 136 * 2;
constexpr int GL_VT = GL_KT + 128 * 72 * 2;
constexpr int GL_ST = GL_VT + 128 * 72 * 2;
constexpr int GL_EB = GL_ST + 128 * 136 * 2;
constexpr int GL_PS = GL_EB + 512;
constexpr int GL_END = GL_PS + 2048;
static_assert(GL_END + 16 <= LDS_BYTES, "GLA LDS");

__device__ __forceinline__ void phase_gla(const Frame& F, int l, int gi, int ng) {
    LAS unsigned char* lds = F.lds;
    const int tid = F.tid, lane = F.lane, w = F.wave, r32 = lane & 31, hh = lane >> 5;
    for (int item = gi; item < 128; item += ng) {
        const int b = item & 7, idx = item >> 3, h = idx >> 2, dir = (idx >> 1) & 1, sl = idx & 1;
        const float* gwp = (dir ? F.in[17] : F.in[15]) + (size_t)l * 16 * 512 + h * 128;
        const float* gbp = (dir ? F.in[18] : F.in[16]) + (size_t)l * 512 + h * 128;
        f16* Oout = dir ? F.OB : F.H16;
        const int d = tid & 127, tg = tid >> 7;
        f16x8 gwf;
#pragma unroll
        for (int j = 0; j < 8; ++j) gwf[j] = (f16)gwp[(hh * 8 + j) * 512 + (w & 3) * 32 + r32];
        const float gbv = gbp[(w & 3) * 32 + r32];
        const int li = tid >> 3, ls = tid & 7;
        const int vi = tid & 63, vs = tid >> 6;
        const int it = w >> 2, et = w & 3;
        const int dt = w >> 1, e2 = (w & 1) * 2;
        f32x16 Sacc[2];
#pragma unroll
        for (int q = 0; q < 2; ++q)
#pragma unroll
            for (int e = 0; e < 16; ++e) Sacc[q][e] = 0.f;
        __syncthreads();
        for (int i = tid; i < 128 * 136 / 2; i += NTHR) ((LAS unsigned*)(lds + GL_ST))[i] = 0u;
        u32x4 pq0, pq1, pk0, pk1, pv0, pv1; f32x2 pg;
        auto chunk_base = [&](int s) -> int { return (s < 4) ? (TL + b * CTXL + (dir ? 3 - s : s) * 64) : (b * SEQ + (dir ? 63 - (s - 4) : (s - 4)) * 64); };
#define GLA_LOAD(s) do { const int _row = chunk_base(s) + (dir ? 63 - li : li); const f16* _zp = F.Z + (size_t)_row * ZLD; \
            pq0 = *(const u32x4*)(_zp + Z_GQ + h * 128 + ls * 16); pq1 = *(const u32x4*)(_zp + Z_GQ + h * 128 + ls * 16 + 8); \
            pk0 = *(const u32x4*)(_zp + Z_GK + h * 128 + ls * 16); pk1 = *(const u32x4*)(_zp + Z_GK + h * 128 + ls * 16 + 8); \
            { const f16* _vp = F.Z + (size_t)(chunk_base(s) + (dir ? 63 - vi : vi)) * ZLD + Z_GV + h * 256 + sl * 128 + vs * 16; pv0 = *(const u32x4*)_vp; pv1 = *(const u32x4*)(_vp + 8); } \
            pg = *(const f32x2*)(F.GLR + (size_t)_row * 32 + dir * 16 + ls * 2); } while (0)
        GLA_LOAD(0);
        for (int s = 0; s < 68; ++s) {
            *(LAS u32x4*)(lds + GL_RQ + (li * 136 + ls * 16) * 2) = pq0; *(LAS u32x4*)(lds + GL_RQ + (li * 136 + ls * 16 + 8) * 2) = pq1;
            *(LAS u32x4*)(lds + GL_RK + (li * 136 + ls * 16) * 2) = pk0; *(LAS u32x4*)(lds + GL_RK + (li * 136 + ls * 16 + 8) * 2) = pk1;
            *(LAS unsigned*)(lds + GL_LR + (li * 16 + ls * 2) * 2) = pk_f16(pg.x, pg.y);
            { const f16x8 va = __builtin_bit_cast(f16x8, pv0), vb = __builtin_bit_cast(f16x8, pv1);
#pragma unroll
              for (int e = 0; e < 8; e += 2) { const unsigned pa = pk_bf16((float)va[e], (float)va[e + 1]), pb = pk_bf16((float)vb[e], (float)vb[e + 1]);
                  *(LAS unsigned short*)(lds + GL_VT + ((vs * 16 + e) * 72 + vi) * 2) = (unsigned short)(pa & 0xffffu);
                  *(LAS unsigned short*)(lds + GL_VT + ((vs * 16 + e + 1) * 72 + vi) * 2) = (unsigned short)(pa >> 16);
                  *(LAS unsigned short*)(lds + GL_VT + ((vs * 16 + 8 + e) * 72 + vi) * 2) = (unsigned short)(pb & 0xffffu);
                  *(LAS unsigned short*)(lds + GL_VT + ((vs * 16 + 8 + e + 1) * 72 + vi) * 2) = (unsigned short)(pb >> 16); } }
            __syncthreads();
            if (s + 1 < 68) GLA_LOAD(s + 1);
            { const f16x8 ga = *(const LAS f16x8*)(lds + GL_LR + ((w >> 2) * 32 + r32) * 32 + hh * 16);
              f32x16 la;
#pragma unroll
              for (int e = 0; e < 16; ++e) la[e] = 0.f;
              la = __builtin_amdgcn_mfma_f32_32x32x16_f16(ga, gwf, la, 0, 0, 0);
#pragma unroll
              for (int e = 0; e < 16; ++e) { const int i = (w >> 2) * 32 + (e & 3) + 8 * (e >> 2) + 4 * hh; const float lg = la[e] + gbv;
                  ((LAS float*)(lds + GL_QT))[i * 128 + (w & 3) * 32 + r32] = (fminf(lg, 0.f) * 1.4426950408889634f - __builtin_amdgcn_logf(1.0f + __builtin_amdgcn_exp2f(fabsf(lg) * -1.4426950408889634f))) * (1.0f / 16.0f); } }
            __syncthreads();
            float bl[16]; float cum = 0.f;
#pragma unroll
            for (int ii = 0; ii < 16; ++ii) { cum += ((const LAS float*)(lds + GL_QT))[(tg * 16 + ii) * 128 + d]; bl[ii] = cum; }
            ((LAS float*)(lds + GL_PS))[tg * 128 + d] = cum;
            __syncthreads();
            float off = 0.f, tot = 0.f;
#pragma unroll
            for (int t2 = 0; t2 < 4; ++t2) { const float pv2 = ((LAS float*)(lds + GL_PS))[t2 * 128 + d]; tot += pv2; if (t2 < tg) off += pv2; }
            const float etot = __builtin_amdgcn_exp2f(tot);
            if (tg == 0) ((LAS float*)(lds + GL_EB))[d] = etot;
            { unsigned ktp[8];
#pragma unroll
              for (int ii = 0; ii < 16; ii += 2) {
                  float kt2[2];
#pragma unroll
                  for (int e = 0; e < 2; ++e) { const int i = tg * 16 + ii + e; const float bi = off + bl[ii + e];
                      const float qv = (float)*(const LAS f16*)(lds + GL_RQ + (i * 136 + d) * 2), kv = (float)*(const LAS f16*)(lds + GL_RK + (i * 136 + d) * 2);
                      const float qt = qv * 0.08838834764831845f * __builtin_amdgcn_exp2f(bi), kh = kv * __builtin_amdgcn_exp2f(-bi); kt2[e] = kh * etot;
                      *(LAS unsigned short*)(lds + GL_QT + (i * 136 + d) * 2) = (unsigned short)(pk_bf16(qt, qt) & 0xffffu);
                      *(LAS unsigned short*)(lds + GL_KH + (i * 136 + d) * 2) = (unsigned short)(pk_bf16(kh, kh) & 0xffffu); }
                  ktp[ii >> 1] = pk_bf16(kt2[0], kt2[1]); }
              *(LAS u32x4*)(lds + GL_KT + (d * 72 + tg * 16) * 2) = (u32x4){ktp[0], ktp[1], ktp[2], ktp[3]};
              *(LAS u32x4*)(lds + GL_KT + (d * 72 + tg * 16 + 8) * 2) = (u32x4){ktp[4], ktp[5], ktp[6], ktp[7]}; }
            __syncthreads();
            f32x16 oacc;
#pragma unroll
            for (int e = 0; e < 16; ++e) oacc[e] = 0.f;
#pragma unroll
            for (int ks = 0; ks < 8; ++ks) {
                const s16x8 a = *(const LAS s16x8*)(lds + GL_QT + ((it * 32 + r32) * 136 + ks * 16 + hh * 8) * 2);
                const s16x8 bb = *(const LAS s16x8*)(lds + GL_ST + ((et * 32 + r32) * 136 + ks * 16 + hh * 8) * 2);
                oacc = __builtin_amdgcn_mfma_f32_32x32x16_bf16(a, bb, oacc, 0, 0, 0); }
            if (w >= 4 && w < 7) {
                const int jt = (w == 6) ? 1 : 0, it2 = (w == 4) ? 0 : 1;
                f32x16 aacc;
#pragma unroll
                for (int e = 0; e < 16; ++e) aacc[e] = 0.f;
#pragma unroll
                for (int ks = 0; ks < 8; ++ks) {
                    const s16x8 a = *(const LAS s16x8*)(lds + GL_KH + ((jt * 32 + r32) * 136 + ks * 16 + hh * 8) * 2);
                    const s16x8 bb = *(const LAS s16x8*)(lds + GL_QT + ((it2 * 32 + r32) * 136 + ks * 16 + hh * 8) * 2);
                    aacc = __builtin_amdgcn_mfma_f32_32x32x16_bf16(a, bb, aacc, 0, 0, 0); }
                const int i = it2 * 32 + r32;
#pragma unroll
                for (int g4 = 0; g4 < 4; ++g4) { const int j0 = jt * 32 + g4 * 8 + hh * 4; float v4[4];
#pragma unroll
                    for (int e = 0; e < 4; ++e) v4[e] = (j0 + e <= i) ? aacc[g4 * 4 + e] : 0.f;
                    *(LAS u32x2*)(lds + GL_AM + (i * 72 + j0) * 2) = (u32x2){pk_bf16(v4[0], v4[1]), pk_bf16(v4[2], v4[3])}; }
            } else if (w == 7) {
#pragma unroll
                for (int q = 0; q < 4; ++q) { const int ci = lane + q * 64, i = ci >> 3, j0 = 32 + (ci & 7) * 4; *(LAS u32x2*)(lds + GL_AM + (i * 72 + j0) * 2) = (u32x2){0u, 0u}; }
            }
            __syncthreads();
#pragma unroll
            for (int ks = 0; ks < 4; ++ks) {
                const s16x8 a = *(const LAS s16x8*)(lds + GL_AM + ((it * 32 + r32) * 72 + ks * 16 + hh * 8) * 2);
                const s16x8 bb = *(const LAS s16x8*)(lds + GL_VT + ((et * 32 + r32) * 72 + ks * 16 + hh * 8) * 2);
                oacc = __builtin_amdgcn_mfma_f32_32x32x16_bf16(a, bb, oacc, 0, 0, 0); }
            { const int cb = chunk_base(s), i0 = it * 32 + 4 * hh; const long rs = dir ? -(long)DM : (long)DM;
              f16* ob = Oout + (size_t)(cb + (dir ? 63 - i0 : i0)) * DM + h * 256 + sl * 128 + et * 32 + r32;
#pragma unroll
              for (int e = 0; e < 16; ++e) ob[((e & 3) + 8 * (e >> 2)) * rs] = (f16)oacc[e]; }
#pragma unroll
            for (int q = 0; q < 2; ++q) {
#pragma unroll
                for (int g4 = 0; g4 < 4; ++g4) { const f32x4 ev = *(const LAS f32x4*)(lds + GL_EB + (dt * 32 + g4 * 8 + hh * 4) * 4);
#pragma unroll
                    for (int e = 0; e < 4; ++e) Sacc[q][g4 * 4 + e] *= ev[e]; }
#pragma unroll
                for (int ks = 0; ks < 4; ++ks) {
                    const s16x8 a = *(const LAS s16x8*)(lds + GL_KT + ((dt * 32 + r32) * 72 + ks * 16 + hh * 8) * 2);
                    const s16x8 bb = *(const LAS s16x8*)(lds + GL_VT + (((e2 + q) * 32 + r32) * 72 + ks * 16 + hh * 8) * 2);
                    Sacc[q] = __builtin_amdgcn_mfma_f32_32x32x16_bf16(a, bb, Sacc[q], 0, 0, 0); }
#pragma unroll
                for (int g4 = 0; g4 < 4; ++g4)
                    *(LAS u32x2*)(lds + GL_ST + (((e2 + q) * 32 + r32) * 136 + dt * 32 + g4 * 8 + hh * 4) * 2) = (u32x2){pk_bf16(Sacc[q][g4 * 4], Sacc[q][g4 * 4 + 1]), pk_bf16(Sacc[q][g4 * 4 + 2], Sacc[q][g4 * 4 + 3])};
            }
            __syncthreads();
        }
#undef GLA_LOAD
    }
}

__device__ __forceinline__ void phase_glacomb(const Frame& F, int l, int nrows) {
    const float* gnw = F.in[19] + l * 256;
    float wv[16];
#pragma unroll
    for (int e = 0; e < 16; ++e) wv[e] = gnw[(F.lane & 15) * 16 + e];
    const int gw = F.bid * 8 + F.wave, nw_ = F.G * 8;
    for (int row = gw; row < nrows; row += nw_) {
        const size_t o = (size_t)row * DM + F.lane * 16;
        const f16x8 a0 = *(const f16x8*)(F.H16 + o), a1 = *(const f16x8*)(F.H16 + o + 8), b0 = *(const f16x8*)(F.OB + o), b1 = *(const f16x8*)(F.OB + o + 8);
        f16* gp = F.Z + (size_t)row * ZLD + Z_GR + F.lane * 16;
        const f16x8 r0 = *(const f16x8*)gp, r1 = *(const f16x8*)(gp + 8);
        float v[16], r[16]; float ss = 0.f;
#pragma unroll
        for (int e = 0; e < 8; ++e) { v[e] = (float)a0[e] + (float)b0[e]; v[8 + e] = (float)a1[e] + (float)b1[e]; r[e] = (float)r0[e]; r[8 + e] = (float)r1[e]; }
#pragma unroll
        for (int e = 0; e < 16; ++e) ss += v[e] * v[e];
        ss += __shfl_xor(ss, 1); ss += __shfl_xor(ss, 2); ss += __shfl_xor(ss, 4); ss += __shfl_xor(ss, 8);
        const float rstd = rsqrtf(ss * (1.0f / 256.0f) + 1e-6f);
        float y[16];
#pragma unroll
        for (int e = 0; e < 16; ++e) y[e] = v[e] * rstd * wv[e] * r[e] * sigmoidf_(r[e]);
        u32x4 w0, w1; w0.x = pk_bf16(y[0], y[1]); w0.y = pk_bf16(y[2], y[3]); w0.z = pk_bf16(y[4], y[5]); w0.w = pk_bf16(y[6], y[7]);
        w1.x = pk_bf16(y[8], y[9]); w1.y = pk_bf16(y[10], y[11]); w1.z = pk_bf16(y[12], y[13]); w1.w = pk_bf16(y[14], y[15]);
        *(u32x4*)gp = w0; *(u32x4*)(gp + 8) = w1;
    }
}

constexpr int AT_K = 0;
constexpr int AT_V = AT_K + 64 * 136 * 2;
constexpr int AT_BUF = AT_V + 128 * 72 * 2;
constexpr int AT_P = 2 * AT_BUF;
constexpr int AT_END = AT_P + 8 * 32 * 72 * 2;
static_assert(AT_END <= LDS_BYTES, "attn LDS");

__device__ __forceinline__ void phase_attn(const Frame& F, int l, bool last, int ai, int na) {
    LAS unsigned char* lds = F.lds;
    const int tid = F.tid, lane = F.lane, w = F.wave, r32 = lane & 31, hh = lane >> 5;
    const int nitems = last ? 1024 : 1088;
    const float* sinkp = F.in[14] + l * 8;
    const int kkey = tid >> 3, kseg = (tid & 7) * 16;
    const int vkp = tid & 31, vdg = tid >> 5;
    LAS unsigned char* Pw = lds + AT_P + w * (32 * 72 * 2);
    for (int item = ai; item < nitems; item += na) {
        int b, qb, hk, hp; bool isctx;
        if (item < 1024) { isctx = false; b = item & 7; const int r = item >> 3; hk = r & 1; hp = (r >> 1) & 1; qb = r >> 2; }
        else { isctx = true; const int r = item - 1024; b = r & 7; hk = (r >> 3) & 1; hp = (r >> 4) & 1; qb = r >> 5; }
        const int hq = hk * 4 + hp * 2 + (w >> 2);
        const int qrow0 = (isctx ? TL + b * CTXL : b * SEQ) + qb * 128 + (w & 3) * 32;
        f16x8 qf[8];
        { const f16* qp = F.Z + (size_t)(qrow0 + r32) * ZLD + Z_AQ + hq * 128 + hh * 8;
#pragma unroll
          for (int s = 0; s < 8; ++s) qf[s] = *(const f16x8*)(qp + s * 16); }
        const float sk = sinkp[hq] * 1.4426950408889634f;
        float mrun = sk, lrun = 1.0f;
        f32x16 oacc[4];
#pragma unroll
        for (int dt = 0; dt < 4; ++dt)
#pragma unroll
            for (int e = 0; e < 16; ++e) oacc[dt][e] = 0.f;
        int wlo = 0, nwin = 0;
        if (!isctx) { const int lo = (qb == 0) ? 0 : qb * 128 - 128, hi = (qb == 31) ? SEQ : qb * 128 + 256; wlo = lo; nwin = (hi - lo) >> 6; }
        const int ntile = nwin + 4;
        const int qpos = qb * 128 + (w & 3) * 32 + r32;
        u32x4 k0, k1, v0, v1;
#define AT_LOAD(t) do { int _kr0; if ((t) < nwin) _kr0 = b * SEQ + wlo + (t) * 64; else _kr0 = TL + b * CTXL + ((t) - nwin) * 64; \
            const f16* _kp = F.Z + (size_t)(_kr0 + kkey) * ZLD + Z_AK + hk * 128 + kseg; k0 = *(const u32x4*)_kp; k1 = *(const u32x4*)(_kp + 8); \
            const f16* _vp = F.Z + (size_t)(_kr0 + 2 * vkp) * ZLD + Z_AV + hk * 128 + vdg * 8; v0 = *(const u32x4*)_vp; v1 = *(const u32x4*)(_vp + ZLD); } while (0)
        AT_LOAD(0);
#define AT_STORE(bo) do { *(LAS u32x4*)(lds + (bo) + AT_K + (kkey * 136 + kseg) * 2) = k0; *(LAS u32x4*)(lds + (bo) + AT_K + (kkey * 136 + kseg + 8) * 2) = k1; \
            const unsigned a0[4] = {v0.x, v0.y, v0.z, v0.w}, a1[4] = {v1.x, v1.y, v1.z, v1.w}; \
            _Pragma("unroll") for (int e = 0; e < 4; ++e) { \
                const unsigned lo = (a0[e] & 0xffffu) | (a1[e] << 16), hi = (a0[e] >> 16) | (a1[e] & 0xffff0000u); \
                *(LAS unsigned*)(lds + (bo) + AT_V + ((vdg * 8 + 2 * e) * 72 + 2 * vkp) * 2) = lo; \
                *(LAS unsigned*)(lds + (bo) + AT_V + ((vdg * 8 + 2 * e + 1) * 72 + 2 * vkp) * 2) = hi; } } while (0)
        __syncthreads();
        AT_STORE(0);
        if (ntile > 1) AT_LOAD(1);
        for (int t = 0; t < ntile; ++t) {
            const int bo = (t & 1) * AT_BUF;
            __syncthreads();
            if (t + 1 < ntile) { AT_STORE(AT_BUF - bo); if (t + 2 < ntile) AT_LOAD(t + 2); }
            const int kpos0 = wlo + t * 64, q0w = qb * 128 + (w & 3) * 32;
            const bool win = (t < nwin) && !(kpos0 <= q0w + 65 && kpos0 >= q0w - 97);
            if ((t < nwin) && (kpos0 > q0w + 159 || kpos0 < q0w - 191)) continue;
            f32x16 sacc[2];
#pragma unroll
            for (int kt = 0; kt < 2; ++kt) {
#pragma unroll
                for (int e = 0; e < 16; ++e) sacc[kt][e] = 0.f;
#pragma unroll
                for (int s = 0; s < 8; ++s) { const f16x8 a = *(const LAS f16x8*)(lds + bo + AT_K + ((kt * 32 + r32) * 136 + s * 16 + hh * 8) * 2);
                    sacc[kt] = __builtin_amdgcn_mfma_f32_32x32x16_f16(a, qf[s], sacc[kt], 0, 0, 0); } }
            float mx = -1e30f;
#pragma unroll
            for (int kt = 0; kt < 2; ++kt)
#pragma unroll
                for (int e = 0; e < 16; ++e) {
                    if (win) { const int kp = kpos0 + kt * 32 + (e & 3) + 8 * (e >> 2) + 4 * hh; const int dd = kp - qpos; if (dd > 128 || dd < -128) sacc[kt][e] = -1e30f; }
                    mx = fmaxf(mx, sacc[kt][e]); }
            mx = fmaxf(mx, __shfl_xor(mx, 32));
            const bool upd = mx > mrun + 8.0f;
            const bool anyupd = __builtin_amdgcn_ballot_w64(upd) != 0ull;
            const float mnew = upd ? mx : mrun;
            float rs = 0.f;
#pragma unroll
            for (int kt = 0; kt < 2; ++kt)
#pragma unroll
                for (int g4 = 0; g4 < 4; ++g4) { float pv4[4];
#pragma unroll
                    for (int e = 0; e < 4; ++e) { pv4[e] = __builtin_amdgcn_exp2f(sacc[kt][g4 * 4 + e] - mnew); rs += pv4[e]; }
                    *(LAS u32x2*)(Pw + (r32 * 72 + kt * 32 + g4 * 8 + hh * 4) * 2) = (u32x2){pk_f16(pv4[0], pv4[1]), pk_f16(pv4[2], pv4[3])}; }
            rs += __shfl_xor(rs, 32);
            if (anyupd) { const float alpha = __builtin_amdgcn_exp2f(mrun - mnew); lrun *= alpha;
#pragma unroll
                for (int dt = 0; dt < 4; ++dt)
#pragma unroll
                    for (int e = 0; e < 16; ++e) oacc[dt][e] *= alpha; }
            lrun += rs; mrun = mnew;
            asm volatile("s_waitcnt lgkmcnt(0)" ::: "memory");
#pragma unroll
            for (int s = 0; s < 4; ++s) { const f16x8 pb = *(const LAS f16x8*)(Pw + (r32 * 72 + s * 16 + hh * 8) * 2);
#pragma unroll
                for (int dt = 0; dt < 4; ++dt) { const f16x8 a = *(const LAS f16x8*)(lds + bo + AT_V + ((dt * 32 + r32) * 72 + s * 16 + hh * 8) * 2);
                    oacc[dt] = __builtin_amdgcn_mfma_f32_32x32x16_f16(a, pb, oacc[dt], 0, 0, 0); } }
        }
#undef AT_LOAD
#undef AT_STORE
        const float inv = 1.0f / lrun;
        f16* op = F.Z + (size_t)(qrow0 + r32) * ZLD + Z_AQ + hq * 128;
#pragma unroll
        for (int dt = 0; dt < 4; ++dt)
#pragma unroll
            for (int g4 = 0; g4 < 4; ++g4)
                *(u32x2*)(op + dt * 32 + g4 * 8 + hh * 4) = (u32x2){pk_bf16(oacc[dt][g4 * 4] * inv, oacc[dt][g4 * 4 + 1] * inv), pk_bf16(oacc[dt][g4 * 4 + 2] * inv, oacc[dt][g4 * 4 + 3] * inv)};
    }
    __syncthreads();
}

#define XB_TMO      128
#define XB_XCNT(j)  (256  + 64 * (j))
#define XB_XSUB(j)  (1280 + 64 * (j))
#define XB_XGEN(j)  (2304 + 64 * (j))
#define XB_TOP      3328
#define XB_TOPGEN   3392
#define XCD_BAR_WORDS 3456
#define XB_SPIN_CAP (1u << 18)

__device__ __forceinline__ unsigned xb_ld(unsigned* p)              { return __hip_atomic_load(p, __ATOMIC_RELAXED, __HIP_MEMORY_SCOPE_AGENT); }
__device__ __forceinline__ unsigned xb_add(unsigned* p, unsigned v) { return __hip_atomic_fetch_add(p, v, __ATOMIC_RELAXED, __HIP_MEMORY_SCOPE_AGENT); }
__device__ __forceinline__ unsigned xb_xcc_id() { return (unsigned)__builtin_amdgcn_s_getreg((3 << 11) | 20) & 0xFu; }
#define XB_SPIN(cond, bar) do { unsigned _sp = 0; while (cond) { __builtin_amdgcn_s_sleep(1); \
    if ((++_sp & 255u) == 0u) { if (xb_ld(&(bar)[XB_TMO])) break; if (_sp > XB_SPIN_CAP) { atomicAdd(&(bar)[XB_TMO], 1u); break; } } } } while (0)

struct XcdBarrier {
    unsigned* bar; unsigned x;
    volatile LAS unsigned* st;
};

__device__ __forceinline__ XcdBarrier xcd_barrier_post(unsigned* bar, volatile LAS unsigned* st) {
    XcdBarrier b; b.bar = bar; b.x = xb_xcc_id(); b.st = st;
    if (threadIdx.x == 0) (void)xb_add(&bar[XB_XCNT(b.x)], 1u);
    return b;
}
__device__ __forceinline__ void xcd_barrier_complete(unsigned* bar, unsigned x, unsigned& nloc, unsigned& nx) {
    const unsigned G = gridDim.x * gridDim.y * gridDim.z;
    unsigned sum, cnt, mine, sp = 0u;
    for (;;) {
        sum = 0u; cnt = 0u; mine = 0u;
#pragma unroll
        for (unsigned j = 0; j < 16; ++j) { const unsigned c = xb_ld(&bar[XB_XCNT(j)]); sum += c; cnt += (c > 0u) ? 1u : 0u; mine = (j == x) ? c : mine; }
        if (sum == G) break;
        __builtin_amdgcn_s_sleep(1);
        if ((++sp & 255u) == 0u) { if (xb_ld(&bar[XB_TMO])) break; if (sp > XB_SPIN_CAP) { atomicAdd(&bar[XB_TMO], 1u); break; } }
    }
    nloc = mine > 0u ? mine : 1u; nx = cnt > 0u ? cnt : 1u;
}

__device__ __forceinline__ void xcd_barrier(const XcdBarrier& b) {
    asm volatile("s_waitcnt vmcnt(0)" ::: "memory");
    __syncthreads();
    if (threadIdx.x == 0) {
        unsigned* bar = b.bar;
        __builtin_amdgcn_s_waitcnt(0);
        unsigned nloc = b.st[0], nx = b.st[1];
        if (nloc == 0u) { xcd_barrier_complete(bar, b.x, nloc, nx); b.st[0] = nloc; b.st[1] = nx; }
        const unsigned old = xb_add(&bar[XB_XSUB(b.x)], 1u);
        const unsigned gen = old / nloc;
        if (old + 1u == (gen + 1u) * nloc) {
            __builtin_amdgcn_fence(__ATOMIC_RELEASE, "agent");
            asm volatile("s_waitcnt vmcnt(0)" ::: "memory");
            const unsigned og = xb_add(&bar[XB_TOP], 1u);
            const unsigned tg = og / nx;
            if (og + 1u == (tg + 1u) * nx) xb_add(&bar[XB_TOPGEN], 1u);
            else XB_SPIN(xb_ld(&bar[XB_TOPGEN]) == tg, bar);
            __builtin_amdgcn_fence(__ATOMIC_ACQUIRE, "agent");
            xb_add(&bar[XB_XGEN(b.x)], 1u);
            asm volatile("s_waitcnt vmcnt(0)" ::: "memory");
        } else {
            XB_SPIN(xb_ld(&bar[XB_XGEN(b.x)]) == gen, bar);
            __builtin_amdgcn_fence(__ATOMIC_ACQUIRE, "agent");
            asm volatile("s_waitcnt vmcnt(0)" ::: "memory");
        }
    }
    __syncthreads();
}


#define gsync(bar_, epoch_) xcd_barrier(xbar)
__device__ __forceinline__ void sub_barrier(unsigned* word, unsigned target) {
    asm volatile("s_waitcnt vmcnt(0) lgkmcnt(0)" ::: "memory");
    __syncthreads();
    if (threadIdx.x == 0) {
        __builtin_amdgcn_fence(__ATOMIC_RELEASE, "agent");
        asm volatile("s_waitcnt vmcnt(0)" ::: "memory");
        (void)__hip_atomic_fetch_add(word, 1u, __ATOMIC_RELAXED, __HIP_MEMORY_SCOPE_AGENT);
        unsigned sp = 0;
        while (__hip_atomic_load(word, __ATOMIC_RELAXED, __HIP_MEMORY_SCOPE_AGENT) < target) { __builtin_amdgcn_s_sleep(2); if (++sp > (1u << 22)) break; }
        __builtin_amdgcn_fence(__ATOMIC_ACQUIRE, "agent");
        asm volatile("s_waitcnt vmcnt(0)" ::: "memory");
    }
    __syncthreads();
}
__device__ __forceinline__ void sub_wait(unsigned* word, unsigned target) {
    if (threadIdx.x == 0) {
        unsigned sp = 0;
        while (__hip_atomic_load(word, __ATOMIC_RELAXED, __HIP_MEMORY_SCOPE_AGENT) < target) { __builtin_amdgcn_s_sleep(2); if (++sp > (1u << 22)) break; }
        __builtin_amdgcn_fence(__ATOMIC_ACQUIRE, "agent");
        asm volatile("s_waitcnt vmcnt(0)" ::: "memory");
    }
    __syncthreads();
}
typedef const __attribute__((address_space(4))) Params* KParamsPtr;
__device__ __forceinline__ Frame mkframe(LAS unsigned char* lds) {
    KParamsPtr kp = (KParamsPtr)__builtin_amdgcn_kernarg_segment_ptr();
    asm volatile("" : "+s"(kp));
    Frame F;
    int tid_ = threadIdx.x, bid_ = blockIdx.x, g_ = gridDim.x;
    asm volatile("" : "+v"(tid_), "+s"(bid_), "+s"(g_));
    F.lds = lds; F.tid = tid_; F.lane = F.tid & 63; F.wave = __builtin_amdgcn_readfirstlane(F.tid >> 6); F.G = g_; F.bid = bid_;
#pragma unroll
    for (int i = 0; i < 23; ++i) F.in[i] = kp->in[i];
    F.out = kp->out; unsigned char* ws = kp->ws; F.ws = ws;
    F.MOD = (float*)(ws + WS_MOD); F.ROPE = (float*)(ws + WS_ROPE); F.W13T = (f16*)(ws + WS_WA); F.W2T = (f16*)(ws + WS_WA + WA_W2);
    F.WINT = (f16*)(ws + WS_WB); F.WBAT = (f16*)(ws + WS_WB + WB_BA); F.WBGT = (f16*)(ws + WS_WB + WB_BG); F.WOUTT = (f16*)(ws + WS_WB + WB_OUT);
    F.XH = (f16*)(ws + WS_XH); F.H16 = (f16*)(ws + WS_H16); F.OB = (f16*)(ws + WS_OB); F.GLR = (float*)(ws + WS_GLR); F.Z = (f16*)(ws + WS_Z);
    return F;
}
#ifndef PMASK
#define PMASK 0xffff
#endif
#ifndef MIX_TEST
#define MIX_TEST 0
#endif
#ifndef STOP_AT
#define STOP_AT 99
#endif
__global__ void __launch_bounds__(NTHR, 2) mega(Params p) {
    extern __shared__ __attribute__((aligned(16))) unsigned char smem[];
    cg::grid_group grid = cg::this_grid();
    LAS unsigned char* lds = (LAS unsigned char*)smem;
    volatile LAS unsigned* xst = (volatile LAS unsigned*)(lds + LDS_BYTES - 16);
    if (threadIdx.x < 4) xst[threadIdx.x] = 0u;
    __syncthreads();
    const XcdBarrier xbar = xcd_barrier_post((unsigned*)(p.ws + WS_BAR), xst);
    grid.sync();
    if (PMASK & 1) { const Frame F = mkframe(lds); phase_mod(F); }
    gsync(bar, epoch);
    for (int l = 0; l < DEPTH; ++l) {
        const bool last = (l == DEPTH - 1);
        const int mrows = last ? TL : TT;
        if (PMASK & 2) { const Frame F = mkframe(lds);
            conv_weight(F, F.in[7] + (size_t)l * DM * 2 * DFF, F.W13T, DM, 2 * DFF, 2 * DFF, 1, F.bid, F.G);
            conv_weight(F, F.in[8] + (size_t)l * DFF * DM, F.W2T, DFF, DM, DM, 3, F.bid, F.G);
            phase_norm(F, F.in[0], F.in[2], (l == 0) ? (const f16*)nullptr : F.XH, l, 0, (l == 0) ? 0 : TL, TT, F.bid, F.G); }
        gsync(bar, epoch);
        if (PMASK & 4) { const Frame F = mkframe(lds); pg8::StaticOrder S; Gemm g{F.H16, F.W13T, TT, 2 * DFF, DM, DM, DM}; S.init(g.M, g.N, F.G, F.bid); EpiSwiglu E{F.Z}; pg8::gemm_phase(F.lds, g, S, E); }
        gsync(bar, epoch);
        if (PMASK & 8) { const Frame F = mkframe(lds); pg8::StaticOrder S; Gemm g{F.Z, F.W2T, TT, DM, DFF, DFF, DFF}; S.init_tail(TL, g.M, g.N, F.G, F.bid);
            EpiResid E{F.in[0], F.in[2], F.XH, F.out, F.MOD + (size_t)l * 9 * NMOD + 2 * DM, 0.5f, l == 0, false};
            unsigned* aw = (unsigned*)(F.ws + WS_BAR + 15360 + 64 * (2 * l)); pg8::gemm_phase(F.lds, g, S, E, aw, 2);
            const int extra = (TL / 256) * 4 + ((TT - TL) / 128) * 4 - 2 * F.G;
            if (extra >= 0 && extra < F.G && F.bid >= extra) { const int ci = F.bid - extra, nc = F.G - extra;
                conv_weight(F, F.in[11] + (size_t)l * DM * INC, F.WINT, DM, INC, NIN, 2, ci, nc);
                conv_weight(F, F.in[20] + (size_t)l * DM * DM, F.WBAT, DM, DM, DM, 3, ci, nc);
                conv_weight(F, F.in[21] + (size_t)l * DM * DM, F.WBGT, DM, DM, DM, 3, ci, nc);
                conv_weight(F, F.in[22] + (size_t)l * DM * DM, F.WOUTT, DM, DM, DM, 3, ci, nc);
                sub_wait(aw, (unsigned)F.G);
                phase_norm(F, F.in[0], F.in[2], F.XH, l, 1, 0, TL, ci, nc); }
            else if (!(extra >= 0 && extra < F.G)) {
                conv_weight(F, F.in[11] + (size_t)l * DM * INC, F.WINT, DM, INC, NIN, 2, F.bid, F.G);
                conv_weight(F, F.in[20] + (size_t)l * DM * DM, F.WBAT, DM, DM, DM, 3, F.bid, F.G);
                conv_weight(F, F.in[21] + (size_t)l * DM * DM, F.WBGT, DM, DM, DM, 3, F.bid, F.G);
                conv_weight(F, F.in[22] + (size_t)l * DM * DM, F.WOUTT, DM, DM, DM, 3, F.bid, F.G);
                sub_wait(aw, (unsigned)F.G); phase_norm(F, F.in[0], F.in[2], F.XH, l, 1, 0, TL, F.bid, F.G); } }
        gsync(bar, epoch);
        if (STOP_AT == 3) return;
        if (PMASK & 2) { const Frame F = mkframe(lds);
            phase_norm(F, F.in[0], F.in[2], F.XH, l, 1, TL, TT, F.bid, F.G); }
        gsync(bar, epoch);
        if (PMASK & 16) { const Frame F = mkframe(lds); pg8::StaticOrder S; Gemm g{F.H16, F.WINT, TT, NIN, DM, DM, DM}; S.init(g.M, g.N, F.G, F.bid); EpiWin E{F.Z, F.GLR}; pg8::gemm_phase(F.lds, g, S, E); }
        gsync(bar, epoch);
        { const Frame F = mkframe(lds); const int sub = (F.bid & 7) + 8 * (F.bid >> 4), half = F.G >> 1;
          if (((F.bid >> 3) & 1) == 0) phase_gla(F, l, sub, half);
          else { phase_qkprep(F, l, last, sub, half); sub_barrier((unsigned*)(F.ws + WS_BAR + 14336 + 256 * l), (unsigned)half); phase_attn(F, l, last, sub, half); } }
        gsync(bar, epoch);
        { const Frame F = mkframe(lds); phase_glacomb(F, l, mrows); }
        gsync(bar, epoch);
        if ((PMASK & 512) && MIX_TEST != 2) { const Frame F = mkframe(lds); pg8::StaticOrder S; Gemm g{F.Z + Z_AQ, F.WBAT, mrows, DM, DM, ZLD, DM}; S.init_tail(TL, g.M, g.N, F.G, F.bid); EpiMerge<false> E{F.H16, F.Z + Z_GA}; pg8::gemm_phase(F.lds, g, S, E); }
        if ((PMASK & 512) && MIX_TEST != 1) { const Frame F = mkframe(lds); pg8::StaticOrder S; Gemm g{F.Z + Z_GR, F.WBGT, mrows, DM, DM, ZLD, DM}; S.init_tail(TL, g.M, g.N, F.G, F.bid); EpiMerge<(MIX_TEST != 2)> E{F.H16, F.Z + Z_GG}; pg8::gemm_phase(F.lds, g, S, E); }
        gsync(bar, epoch);
        if (PMASK & 1024) { const Frame F = mkframe(lds); pg8::StaticOrder S; Gemm g{F.H16, F.WOUTT, mrows, DM, DM, DM, DM}; S.init_tail(TL, g.M, g.N, F.G, F.bid);
            EpiResid E{F.in[0], F.in[2], F.XH, F.out, F.MOD + (size_t)l * 9 * NMOD + 5 * DM, 1.0f, false, false}; pg8::gemm_phase(F.lds, g, S, E);
            int extra = (TL / 256) * 4 + ((mrows - TL) / 128) * 4 - 2 * F.G; if (extra < 0 || extra >= F.G) extra = 0;
            if (F.bid >= extra) { const int ci = F.bid - extra, nc = F.G - extra;
                conv_weight(F, F.in[9] + (size_t)l * DM * 2 * DFF, F.W13T, DM, 2 * DFF, 2 * DFF, 1, ci, nc);
                conv_weight(F, F.in[10] + (size_t)l * DFF * DM, F.W2T, DFF, DM, DM, 3, ci, nc); } }
        gsync(bar, epoch);
        if (STOP_AT == 9) return;
        if (PMASK & 2) { const Frame F = mkframe(lds);
            phase_norm(F, F.in[0], F.in[2], F.XH, l, 2, 0, mrows, F.bid, F.G); }
        gsync(bar, epoch);
        if (PMASK & 4) { const Frame F = mkframe(lds); pg8::StaticOrder S; Gemm g{F.H16, F.W13T, mrows, 2 * DFF, DM, DM, DM}; S.init(g.M, g.N, F.G, F.bid); EpiSwiglu E{F.Z}; pg8::gemm_phase(F.lds, g, S, E); }
        gsync(bar, epoch);
        if (PMASK & 8) { const Frame F = mkframe(lds); pg8::StaticOrder S; Gemm g{F.Z, F.W2T, mrows, DM, DFF, DFF, DFF}; S.init_tail(TL, g.M, g.N, F.G, F.bid);
            EpiResid E{F.in[0], F.in[2], F.XH, F.out, F.MOD + (size_t)l * 9 * NMOD + 8 * DM, 0.5f, false, last};
            unsigned* aw = (unsigned*)(F.ws + WS_BAR + 15360 + 64 * (2 * l + 1)); pg8::gemm_phase(F.lds, g, S, E, last ? (unsigned*)nullptr : aw, 2);
            if (!last) { int extra = (TL / 256) * 4 + ((mrows - TL) / 128) * 4 - 2 * F.G; if (extra < 0 || extra >= F.G) extra = 0;
                if (F.bid >= extra) { sub_wait(aw, (unsigned)F.G); phase_norm(F, F.in[0], F.in[2], F.XH, l + 1, 0, 0, TL, F.bid - extra, F.G - extra); } } }
        gsync(bar, epoch);
    }
}

extern "C" void kernel_launch(void* const* d_in, const int* in_sizes, int n_in, void* d_out, int out_size, void* d_ws, size_t ws_size, hipStream_t stream) {
    static int grid = 0;
    if (grid == 0) {
        if (n_in != 23 || ws_size < WS_END) { fprintf(stderr, "kernel_launch: need 23 inputs and %zu bytes of workspace (got %d, %zu)\n", (size_t)WS_END, n_in, ws_size); grid = -1; return; }
        int dev = 0, cus = 0, per_cu = 0;
        hipGetDevice(&dev); hipDeviceGetAttribute(&cus, hipDeviceAttributeMultiprocessorCount, dev);
        if (hipFuncSetAttribute((const void*)mega, hipFuncAttributeMaxDynamicSharedMemorySize, LDS_BYTES) != hipSuccess) { fprintf(stderr, "kernel_launch: hipFuncSetAttribute failed\n"); grid = -1; return; }
        if (hipOccupancyMaxActiveBlocksPerMultiprocessor(&per_cu, (const void*)mega, NTHR, LDS_BYTES) != hipSuccess || per_cu < 1) { fprintf(stderr, "kernel_launch: occupancy query says %d\n", per_cu); per_cu = 1; }
        (void)hipGetLastError();
        grid = cus;
    }
    if (grid < 0) return;
    if (hipMemsetAsync((char*)d_ws + WS_BAR, 0, 16384, stream) != hipSuccess) { fprintf(stderr, "kernel_launch: memset failed\n"); return; }
    Params p{};
    for (int i = 0; i < 23; ++i) p.in[i] = (const float*)d_in[i];
    p.out = (float*)d_out; p.ws = (unsigned char*)d_ws;
    void* args[] = {&p};
    hipError_t e = hipLaunchCooperativeKernel((const void*)mega, dim3(grid), dim3(NTHR), args, LDS_BYTES, stream);
    if (e != hipSuccess) fprintf(stderr, "kernel_launch: cooperative launch failed: %s (grid %d)\n", hipGetErrorString(e), grid);
}
```

```cpp
#include <hip/hip_runtime.h>
#include <hip/hip_cooperative_groups.h>
#include <cstdio>
#include <cstdint>
namespace cg = cooperative_groups;

#define LAS __attribute__((address_space(3)))
typedef _Float16 f16;
typedef _Float16 f16x8 __attribute__((ext_vector_type(8)));
typedef _Float16 f16x4 __attribute__((ext_vector_type(4)));
typedef _Float16 f16x2 __attribute__((ext_vector_type(2)));
typedef short s16x8 __attribute__((ext_vector_type(8)));
typedef float f32x2 __attribute__((ext_vector_type(2)));
typedef float f32x4 __attribute__((ext_vector_type(4)));
typedef float f32x16 __attribute__((ext_vector_type(16)));
typedef unsigned u32x2 __attribute__((ext_vector_type(2)));
typedef unsigned u32x4 __attribute__((ext_vector_type(4)));

constexpr int DM = 1024, NB = 8, SEQ = 4096, DEPTH = 4, CTXL = 256, DFF = 2816;
constexpr int TL = NB * SEQ, TC = NB * CTXL, TT = TL + TC;
constexpr int NMOD = 9 * DM;
constexpr int INC = 6688;
constexpr int ZLD = 6656;
constexpr int Z_AK = 0, Z_AV = 256, Z_GK = 512, Z_GV = 1024, Z_AQ = 2048, Z_GQ = 3072, Z_GR = 3584, Z_GA = 4608, Z_GG = 5632;
constexpr int NIN = 6912;
constexpr int NTHR = 512;
constexpr int LDS_BYTES = 148480;

constexpr size_t WS_MOD = 0;
constexpr size_t WS_ROPE = WS_MOD + (size_t)DEPTH * 9 * NMOD * 4;
constexpr size_t WS_WA = WS_ROPE + 64 * 32 * 2 * 4;
constexpr size_t WA_W2 = (size_t)2 * DFF * DM * 2;
constexpr size_t WS_WB = WS_WA + WA_W2 + (size_t)DM * DFF * 2;
constexpr size_t WB_BA = (size_t)NIN * DM * 2, WB_BG = WB_BA + (size_t)DM * DM * 2, WB_OUT = WB_BG + (size_t)DM * DM * 2;
constexpr size_t WS_XH = WS_WB + WB_OUT + (size_t)DM * DM * 2;
constexpr size_t WS_H16 = WS_XH + (size_t)TT * DM * 2;
constexpr size_t WS_OB = WS_H16 + (size_t)TT * DM * 2;
constexpr size_t WS_GLR = WS_OB + (size_t)TT * DM * 2;
constexpr size_t WS_Z = WS_GLR + (size_t)TT * 32 * 4;
constexpr size_t WS_BAR = WS_Z + (size_t)TT * ZLD * 2;
constexpr size_t WS_END = WS_BAR + 16384;

struct Params {
    const float* in[23];
    float* out;
    unsigned char* ws;
};

__device__ __forceinline__ unsigned pk_f16(float a, float b) { f16x2 v; v.x = (f16)a; v.y = (f16)b; return __builtin_bit_cast(unsigned, v); }
typedef __bf16 bf16x2_t __attribute__((ext_vector_type(2)));
__device__ __forceinline__ unsigned pk_bf16(float lo, float hi) { f32x2 v; v.x = lo; v.y = hi; const bf16x2_t b = __builtin_convertvector(v, bf16x2_t); return __builtin_bit_cast(unsigned, b); }
__device__ __forceinline__ float sigmoidf_(float x) { return __builtin_amdgcn_rcpf(1.0f + __builtin_amdgcn_exp2f(x * -1.4426950408889634f)); }
__device__ __forceinline__ float wave_sum(float v) {
#pragma unroll
    for (int o = 32; o >= 1; o >>= 1) v += __shfl_xor(v, o);
    return v;
}

namespace pg8 {
constexpr int BM = 256, BK = 64, HALF = 128, HTB = HALF * BK * 2, STAGE_BYTES = 8 * HTB, NXCD = 8, WGM = 8;
__host__ __device__ __forceinline__ int lds_byte(int r, int c) { const int st = (r >> 4) * 2 + (c >> 5), rr = r & 15, cc = c & 31, ob = rr * 64 + cc * 2; return st * 1024 + (ob ^ (((ob >> 9) & 1) << 5)); }
__host__ __device__ __forceinline__ void stage_rc(int b, int& R, int& C) { const int st = b / 1024, sb = b % 1024, swz = sb ^ (((sb >> 9) & 1) << 5); R = (st >> 1) * 16 + swz / 64; C = (st & 1) * 32 + (swz % 64) / 2; }
__host__ __device__ __forceinline__ int perm32(int rho) { const int n = rho >> 4, i = rho & 15; return 8 * (i >> 2) + 4 * n + (i & 3); }
struct Unit { int pm, pn, roff, half; };
struct Gemm { const f16* A; const f16* Bt; int M, N, K, lda, ldb; };
struct StaticOrder {
    int nM, nN, nwg, G, c, nhalf;
    __device__ void init(int M, int N, int G_, int c_) { nM = M / BM; nN = N / BM; nwg = nM * nN; G = G_; c = c_; nhalf = 0; }
    __device__ void init_tail(int Mfull, int M, int N, int G_, int c_) { nM = Mfull / BM; nN = N / BM; nwg = nM * nN; G = G_; c = c_; nhalf = ((M - Mfull) / HALF) * nN; }
    __device__ bool next(int i, Unit& u) const {
        const long L = (long)i * G + c; if (L >= nwg + nhalf) return false;
        if (L >= nwg) { const int hx = (int)L - nwg, hp = hx / nN; u.pn = hx % nN; u.pm = nM + (hp >> 1); u.roff = (hp & 1) * HALF; u.half = 1; return true; }
        int wgid = (int)L; { const int q = nwg / NXCD, r = nwg % NXCD, xcd = wgid % NXCD, off = wgid / NXCD; wgid = (xcd < r ? xcd * (q + 1) : r * (q + 1) + (xcd - r) * q) + off; }
        const int nig = WGM * nN, gid = wgid / nig, fm = gid * WGM, gsz = (nM - fm) < WGM ? (nM - fm) : WGM;
        u.pm = fm + ((wgid % nig) % gsz); u.pn = (wgid % nig) / gsz; u.roff = 0; u.half = 0; return true;
    }
};

#ifndef PG8_SP2
#define PG8_SP2 true
#endif
#ifndef PG8_ALIGN
#define PG8_ALIGN true
#endif
template <bool BF16> __device__ __forceinline__ f32x4 mma16_(f16x8 b, f16x8 a, f32x4 c) {
    if constexpr (BF16) return __builtin_amdgcn_mfma_f32_16x16x32_bf16(__builtin_bit_cast(s16x8, b), __builtin_bit_cast(s16x8, a), c, 0, 0, 0);
    else return __builtin_amdgcn_mfma_f32_16x16x32_f16(b, a, c, 0, 0, 0);
}
template <class Epi, bool ALIGN_EPI = PG8_ALIGN, bool SP2 = PG8_SP2>
__device__ __forceinline__ void gemm_phase(LAS unsigned char* lds, const Gemm g, const StaticOrder& S, const Epi& E, unsigned* arrive_word = nullptr, int arrive_after = 0) {
    int tid_ = threadIdx.x; asm volatile("" : "+v"(tid_));
    const int tid = tid_, wid = __builtin_amdgcn_readfirstlane(tid >> 6), lane = tid & 63, wr = wid >> 2, wc = wid & 3, fr = lane & 15, fq = lane >> 4;
    const int K = g.K, nt = K / BK;
    unsigned voffA[2], voffB[2];
#pragma unroll
    for (int i = 0; i < 2; ++i) { int R, C; stage_rc(tid * 16 + i * 8192, R, C); const int Rb = Epi::PERM ? ((R & ~31) + perm32(R & 31)) : R;
        voffA[i] = (unsigned)(R * g.lda + C) * 2u; voffB[i] = (unsigned)(Rb * g.ldb + C) * 2u; }
    const size_t kstep = (size_t)(BK * 2);
    const size_t hA = (size_t)HALF * g.lda * 2, hB = (size_t)HALF * g.ldb * 2;
    const size_t tA = 2 * hA, tB = 2 * hB;
    const unsigned ldsw = (unsigned)wid * 1024u;
    const int aoff = lds_byte(wr * 64 + fr, fq * 8), boff = lds_byte(wc * 32 + fr, fq * 8);
#define PG8_SA(b, h) (((b) * 2 + (h)) * HTB)
#define PG8_SB(b, h) ((4 + (b) * 2 + (h)) * HTB)
#define PG8_STAGE(bufoff, gbase, voff) do { _Pragma("unroll") for (int _i = 0; _i < 2; ++_i) \
        __builtin_amdgcn_global_load_lds((const unsigned*)((const char*)(gbase) + (voff)[_i]), (LAS unsigned*)(lds + (bufoff) + ldsw + _i * 8192), 16, 0, 0); } while (0)
#define PG8_LDA(dst, b, h) do { _Pragma("unroll") for (int m = 0; m < 4; ++m) _Pragma("unroll") for (int k = 0; k < 2; ++k) dst[m][k] = *(const LAS f16x8*)(lds + PG8_SA(b, h) + aoff + m * 2048 + k * 1024); } while (0)
#define PG8_LDB(dst, b, h) do { _Pragma("unroll") for (int n = 0; n < 2; ++n) _Pragma("unroll") for (int k = 0; k < 2; ++k) dst[n][k] = *(const LAS f16x8*)(lds + PG8_SB(b, h) + boff + n * 2048 + k * 1024); } while (0)
#define PG8_MMA(ai, bj, At, Bt) do { __builtin_amdgcn_s_setprio(1); _Pragma("unroll") for (int m = 0; m < 4; ++m) _Pragma("unroll") for (int n = 0; n < 2; ++n) _Pragma("unroll") for (int k = 0; k < 2; ++k) \
        acc[ai][bj][m][n] = mma16_<Epi::BF16>(Bt[n][k], At[m][k], acc[ai][bj][m][n]); __builtin_amdgcn_s_setprio(0); } while (0)
#define PG8_WAIT_V(n) asm volatile("s_waitcnt vmcnt(" #n ")" ::: "memory")
#define PG8_WAIT_L(n) asm volatile("s_waitcnt lgkmcnt(" #n ")" ::: "memory")
#define PG8_BAR __builtin_amdgcn_s_barrier()
#define PG8_SCHED __builtin_amdgcn_sched_barrier(0)
    Unit cur, nxt; int ui = 0;
    if (!S.next(0, cur)) return;
    f32x4 acc[2][2][4][2];
#pragma unroll
    for (int a = 0; a < 2; ++a)
#pragma unroll
        for (int b = 0; b < 2; ++b)
#pragma unroll
            for (int m = 0; m < 4; ++m)
#pragma unroll
                for (int n = 0; n < 2; ++n) acc[a][b][m][n] = (f32x4){0.f, 0.f, 0.f, 0.f};
    f16x8 At[4][2], B0[2][2], B1[2][2];
    const char* cA = (const char*)g.A + (size_t)cur.pm * tA + (cur.roff ? hA : (size_t)0); const char* cB = (const char*)g.Bt + (size_t)cur.pn * tB;
    if constexpr (SP2) {
        PG8_STAGE(PG8_SB(0, 0), cB, voffB); PG8_STAGE(PG8_SB(0, 1), cB + hB, voffB); PG8_STAGE(PG8_SA(0, 0), cA, voffA); PG8_STAGE(PG8_SA(0, 1), cA + hA, voffA);
        if (wr == 1) PG8_BAR;
        PG8_WAIT_V(2); PG8_BAR;
        PG8_STAGE(PG8_SB(1, 0), cB + kstep, voffB); PG8_STAGE(PG8_SA(1, 0), cA + kstep, voffA); PG8_STAGE(PG8_SB(1, 1), cB + hB + kstep, voffB);
        PG8_WAIT_V(6); PG8_BAR;
    } else {
        PG8_STAGE(PG8_SB(0, 0), cB, voffB); PG8_STAGE(PG8_SA(0, 0), cA, voffA); PG8_STAGE(PG8_SB(0, 1), cB + hB, voffB); PG8_STAGE(PG8_SA(0, 1), cA + hA, voffA);
        if (wr == 1) PG8_BAR;
        PG8_WAIT_V(4); PG8_BAR;
        PG8_STAGE(PG8_SB(1, 0), cB + kstep, voffB); PG8_STAGE(PG8_SA(1, 0), cA + kstep, voffA); PG8_STAGE(PG8_SB(1, 1), cB + hB + kstep, voffB);
        PG8_WAIT_V(6); PG8_BAR;
    }
    for (;;) {
        const bool has_next = S.next(ui + 1, nxt);
        const char* nA = has_next ? (const char*)g.A + (size_t)nxt.pm * tA + (nxt.roff ? hA : (size_t)0) : cA; const char* nB = has_next ? (const char*)g.Bt + (size_t)nxt.pn * tB : cB;
        for (int t = 0; t < nt; t += 2) {
            const bool last = (t == nt - 2);
            const char* a1 = cA + (size_t)(t + 1) * kstep;
            const char* a2 = last ? nA : cA + (size_t)(t + 2) * kstep; const char* b2 = last ? nB : cB + (size_t)(t + 2) * kstep;
            const char* a3 = a2 + kstep; const char* b3 = b2 + kstep;
            if constexpr (SP2) {
            PG8_LDB(B0, 0, 0); PG8_LDB(B1, 0, 1); PG8_SCHED; PG8_LDA(At, 0, 0); PG8_STAGE(PG8_SA(1, 1), a1 + hA, voffA);
            PG8_WAIT_V(8); PG8_WAIT_L(0); PG8_BAR; PG8_MMA(0, 0, At, B0); PG8_MMA(0, 1, At, B1); PG8_BAR; PG8_SCHED;
            PG8_LDA(At, 0, 1); PG8_STAGE(PG8_SB(0, 0), b2, voffB); PG8_STAGE(PG8_SB(0, 1), b2 + hB, voffB); PG8_STAGE(PG8_SA(0, 0), a2, voffA);
            PG8_WAIT_V(8); PG8_WAIT_L(0); PG8_BAR; if (!cur.half) { PG8_MMA(1, 0, At, B0); PG8_MMA(1, 1, At, B1); } PG8_BAR; PG8_SCHED;
            PG8_LDB(B0, 1, 0); PG8_LDB(B1, 1, 1); PG8_SCHED; PG8_LDA(At, 1, 0); PG8_STAGE(PG8_SA(0, 1), a2 + hA, voffA);
            PG8_WAIT_V(8); PG8_WAIT_L(0); PG8_BAR; PG8_MMA(0, 0, At, B0); PG8_MMA(0, 1, At, B1); PG8_BAR; PG8_SCHED;
            PG8_LDA(At, 1, 1); PG8_STAGE(PG8_SB(1, 0), b3, voffB); PG8_STAGE(PG8_SB(1, 1), b3 + hB, voffB); PG8_STAGE(PG8_SA(1, 0), a3, voffA);
            PG8_WAIT_V(8); PG8_WAIT_L(0); PG8_BAR; if (!cur.half) { PG8_MMA(1, 0, At, B0); PG8_MMA(1, 1, At, B1); } PG8_BAR; PG8_SCHED;
            } else {
            PG8_LDB(B0, 0, 0); PG8_SCHED; PG8_LDA(At, 0, 0); PG8_STAGE(PG8_SA(1, 1), a1 + hA, voffA);
            PG8_WAIT_L(8); PG8_BAR; PG8_WAIT_L(0); PG8_MMA(0, 0, At, B0); PG8_BAR; PG8_SCHED;
            PG8_LDB(B1, 0, 1); PG8_STAGE(PG8_SB(0, 0), b2, voffB);
            PG8_BAR; PG8_WAIT_L(0); PG8_MMA(0, 1, At, B1); PG8_BAR;
            PG8_LDA(At, 0, 1); PG8_STAGE(PG8_SA(0, 0), a2, voffA);
            PG8_BAR; PG8_WAIT_L(0); if (!cur.half) PG8_MMA(1, 0, At, B0); PG8_BAR; PG8_SCHED;
            PG8_STAGE(PG8_SB(0, 1), b2 + hB, voffB);
            PG8_WAIT_V(6); PG8_BAR; if (!cur.half) PG8_MMA(1, 1, At, B1); PG8_BAR;
            PG8_LDB(B0, 1, 0); PG8_SCHED; PG8_LDA(At, 1, 0); PG8_STAGE(PG8_SA(0, 1), a2 + hA, voffA);
            PG8_WAIT_L(8); PG8_BAR; PG8_WAIT_L(0); PG8_MMA(0, 0, At, B0); PG8_BAR; PG8_SCHED;
            PG8_LDB(B1, 1, 1); PG8_STAGE(PG8_SB(1, 0), b3, voffB);
            PG8_BAR; PG8_WAIT_L(0); PG8_MMA(0, 1, At, B1); PG8_BAR;
            PG8_LDA(At, 1, 1); PG8_STAGE(PG8_SA(1, 0), a3, voffA);
            PG8_BAR; PG8_WAIT_L(0); if (!cur.half) PG8_MMA(1, 0, At, B0); PG8_BAR; PG8_SCHED;
            PG8_STAGE(PG8_SB(1, 1), b3 + hB, voffB);
            PG8_WAIT_V(6); PG8_BAR; if (!cur.half) PG8_MMA(1, 1, At, B1); PG8_BAR;
            }
        }
        if constexpr (ALIGN_EPI) { if (wr == 0) PG8_BAR; }
        E(acc, cur, wr, wc, fr, fq);
        if (ALIGN_EPI && arrive_word && ui + 1 == arrive_after) {
            asm volatile("s_waitcnt vmcnt(0) lgkmcnt(0)" ::: "memory"); PG8_BAR;
            if (tid == 0) { __builtin_amdgcn_fence(__ATOMIC_RELEASE, "agent"); asm volatile("s_waitcnt vmcnt(0)" ::: "memory");
                (void)__hip_atomic_fetch_add(arrive_word, 1u, __ATOMIC_RELAXED, __HIP_MEMORY_SCOPE_AGENT); } }
        if (!has_next) break;
#pragma unroll
        for (int a = 0; a < 2; ++a)
#pragma unroll
            for (int b = 0; b < 2; ++b)
#pragma unroll
                for (int m = 0; m < 4; ++m)
#pragma unroll
                    for (int n = 0; n < 2; ++n) acc[a][b][m][n] = (f32x4){0.f, 0.f, 0.f, 0.f};
        cur = nxt; cA = nA; cB = nB; ++ui;
        if constexpr (ALIGN_EPI) { if (wr == 1) PG8_BAR; }
    }
    PG8_WAIT_V(0);
    if constexpr (!ALIGN_EPI) { if (wr == 0) PG8_BAR; }
    PG8_BAR;
#undef PG8_SA
#undef PG8_SB
#undef PG8_STAGE
#undef PG8_LDA
#undef PG8_LDB
#undef PG8_MMA
#undef PG8_WAIT_V
#undef PG8_WAIT_L
#undef PG8_BAR
#undef PG8_SCHED
}
}
using pg8::Unit;
using pg8::Gemm;

struct EpiSwiglu {
    static constexpr bool PERM = true, BF16 = true;
    f16* O;
    __device__ __forceinline__ void operator()(const f32x4 (&acc)[2][2][4][2], const Unit& u, int wr, int wc, int fr, int fq) const {
        const int row0 = u.pm * 256 + wr * 64 + fr, col0 = u.pn * 128 + wc * 32 + 8 * fq;
#pragma unroll
        for (int ai = 0; ai < 2; ++ai)
#pragma unroll
            for (int m = 0; m < 4; ++m) {
                float o[8];
#pragma unroll
                for (int n = 0; n < 2; ++n)
#pragma unroll
                    for (int j = 0; j < 4; ++j) { const float up = acc[ai][0][m][n][j], gt = acc[ai][1][m][n][j]; o[n * 4 + j] = up * gt * sigmoidf_(gt); }
                u32x4 w; w.x = pk_bf16(o[0], o[1]); w.y = pk_bf16(o[2], o[3]); w.z = pk_bf16(o[4], o[5]); w.w = pk_bf16(o[6], o[7]);
                *(u32x4*)(O + (size_t)(row0 + ai * 128 + m * 16) * DFF + col0) = w;
            }
    }
};
struct EpiResid {
    static constexpr bool PERM = true, BF16 = true;
    const float* xl_src; const float* xc_src; f16* XH; float* out32; const float* gate; float coef; bool SRC32, DST32;
    __device__ __forceinline__ void operator()(const f32x4 (&acc)[2][2][4][2], const Unit& u, int wr, int wc, int fr, int fq) const {
        const bool lat = u.pm < 128; const int mi = lat ? (u.pm >> 4) : 8;
        const size_t inrow = (size_t)(u.roff + wr * 64 + fr) * DM + u.pn * 256 + wc * 32 + 8 * fq;
        const size_t gofs = (size_t)u.pm * 256 * DM + inrow;
        const float* s32 = (lat ? xl_src : xc_src) + (size_t)(lat ? u.pm : u.pm - 128) * 256 * DM + inrow;
        const float* gp = gate + (size_t)mi * NMOD + u.pn * 256 + wc * 32 + 8 * fq;
#pragma unroll
        for (int bj = 0; bj < 2; ++bj) { const f32x4 g0 = *(const f32x4*)(gp + bj * 128) * coef, g1 = *(const f32x4*)(gp + bj * 128 + 4) * coef;
#pragma unroll
            for (int ai = 0; ai < 2; ++ai) { if (ai == 1 && u.half) break;
#pragma unroll
                for (int m = 0; m < 4; ++m) { const size_t ro = (size_t)(ai * 128 + m * 16) * DM + bj * 128;
                    f32x4 x0, x1;
                    if (SRC32) { x0 = *(const f32x4*)(s32 + ro); x1 = *(const f32x4*)(s32 + ro + 4); }
                    else { const f16x8 t = *(const f16x8*)(XH + gofs + ro); x0 = (f32x4){(float)t[0], (float)t[1], (float)t[2], (float)t[3]}; x1 = (f32x4){(float)t[4], (float)t[5], (float)t[6], (float)t[7]}; }
                    x0 += g0 * acc[ai][bj][m][0]; x1 += g1 * acc[ai][bj][m][1];
                    if (DST32) { *(f32x4*)(out32 + gofs + ro) = x0; *(f32x4*)(out32 + gofs + ro + 4) = x1; }
                    else { u32x4 w; w.x = pk_f16(x0[0], x0[1]); w.y = pk_f16(x0[2], x0[3]); w.z = pk_f16(x1[0], x1[1]); w.w = pk_f16(x1[2], x1[3]); *(u32x4*)(XH + gofs + ro) = w; } } } }
    }
};
struct EpiWin {
    static constexpr bool PERM = true, BF16 = true;
    f16* Z; float* GLR;
    __device__ __forceinline__ void operator()(const f32x4 (&acc)[2][2][4][2], const Unit& u, int wr, int wc, int fr, int fq) const {
        const int row0 = u.pm * 256 + wr * 64 + fr;
        if (u.pn < 26) {
            const int col0 = u.pn * 256 + wc * 32 + 8 * fq;
#pragma unroll
            for (int ai = 0; ai < 2; ++ai)
#pragma unroll
                for (int m = 0; m < 4; ++m) { f16* rowp = Z + (size_t)(row0 + ai * 128 + m * 16) * ZLD + col0;
#pragma unroll
                    for (int bj = 0; bj < 2; ++bj) { const f32x4 v0 = acc[ai][bj][m][0], v1 = acc[ai][bj][m][1];
                        u32x4 w; w.x = pk_f16(v0[0], v0[1]); w.y = pk_f16(v0[2], v0[3]); w.z = pk_f16(v1[0], v1[1]); w.w = pk_f16(v1[2], v1[3]);
                        *(u32x4*)(rowp + bj * 128) = w; } }
        } else if (wc == 0) {
#pragma unroll
            for (int ai = 0; ai < 2; ++ai)
#pragma unroll
                for (int m = 0; m < 4; ++m) { float* rowp = GLR + (size_t)(row0 + ai * 128 + m * 16) * 32 + 8 * fq;
                    *(f32x4*)(rowp) = acc[ai][0][m][0]; *(f32x4*)(rowp + 4) = acc[ai][0][m][1]; }
        }
    }
};
template <bool SECOND> struct EpiMerge {
    static constexpr bool PERM = true, BF16 = false;
    f16* M16; const f16* G;
    __device__ __forceinline__ void operator()(const f32x4 (&acc)[2][2][4][2], const Unit& u, int wr, int wc, int fr, int fq) const {
        const int row0 = u.pm * 256 + u.roff + wr * 64 + fr, col0 = u.pn * 256 + wc * 32 + 8 * fq;
#pragma unroll
        for (int ai = 0; ai < 2; ++ai) { if (ai == 1 && u.half) break;
#pragma unroll
            for (int m = 0; m < 4; ++m) { const size_t r = (size_t)(row0 + ai * 128 + m * 16);
#pragma unroll
                for (int bj = 0; bj < 2; ++bj) {
                    const f16x8 gt = *(const f16x8*)(G + r * ZLD + col0 + bj * 128);
                    f16* mp = M16 + r * DM + col0 + bj * 128;
                    float o[8];
#pragma unroll
                    for (int n = 0; n < 2; ++n)
#pragma unroll
                        for (int j = 0; j < 4; ++j) o[n * 4 + j] = sigmoidf_((float)gt[n * 4 + j]) * acc[ai][bj][m][n][j];
                    if (SECOND) { const u32x4 pv = *(const u32x4*)mp; const unsigned pw[4] = {pv.x, pv.y, pv.z, pv.w};
#pragma unroll
                        for (int e = 0; e < 4; ++e) { o[2 * e] += __uint_as_float(pw[e] << 16); o[2 * e + 1] += __uint_as_float(pw[e] & 0xffff0000u); } }
                    u32x4 w; w.x = pk_bf16(o[0], o[1]); w.y = pk_bf16(o[2], o[3]); w.z = pk_bf16(o[4], o[5]); w.w = pk_bf16(o[6], o[7]);
                    *(u32x4*)mp = w; } } }
    }
};

struct Frame {
    LAS unsigned char* lds; int tid, lane, wave, G, bid;
    const float* in[23]; float* out; unsigned char* ws;
    float* MOD; float* ROPE; f16* W13T; f16* W2T; f16* WINT; f16* WBAT; f16* WBGT; f16* WOUTT; f16* XH; f16* H16; f16* OB; float* GLR; f16* Z;
};

__device__ __forceinline__ void conv_weight(const Frame& F, const float* src, f16* dst, int K, int ld, int Nd, int mode, int ci, int nc) {
    LAS f16* tile = (LAS f16*)F.lds;
    const int nkt = K / 128, nitems = (Nd / 64) * nkt;
    for (int it = ci; it < nitems; it += nc) {
        const int nt = it / nkt, kt = it % nkt, n0 = nt * 64;
        int sc = n0, valid = 64;
        if (mode == 1) { const int pn = n0 >> 8, w = n0 & 255; sc = (w < 128) ? (pn * 128 + w) : (DFF + pn * 128 + w - 128); }
        else if (mode == 2) { if (n0 < 2048) sc = n0; else if (n0 < 6656) sc = n0 + 32; else if (n0 == 6656) { sc = 2048; valid = 32; } else { sc = 0; valid = 0; } }
        __syncthreads();
#pragma unroll
        for (int q = 0; q < 4; ++q) {
            const int idx = F.tid + q * NTHR, kr = idx >> 4, c4 = (idx & 15) * 4;
            f32x4 v = (f32x4){0.f, 0.f, 0.f, 0.f};
            if (c4 < valid) v = *(const f32x4*)(src + (size_t)(kt * 128 + kr) * ld + sc + c4);
#pragma unroll
            for (int e = 0; e < 4; ++e) { if (mode != 0) ((LAS unsigned short*)tile)[(c4 + e) * 136 + kr] = (unsigned short)(pk_bf16(v[e], v[e]) & 0xffffu); else tile[(c4 + e) * 136 + kr] = (f16)v[e]; }
        }
        __syncthreads();
#pragma unroll
        for (int q = 0; q < 2; ++q) {
            const int ch = F.tid + q * NTHR, n = ch >> 4, kc = (ch & 15) * 8;
            *(u32x4*)(dst + (size_t)(n0 + n) * K + kt * 128 + kc) = *(const LAS u32x4*)(tile + n * 136 + kc);
        }
    }
    __syncthreads();
}

__device__ __forceinline__ void phase_mod(const Frame& F) {
    LAS float* cond = (LAS float*)F.lds;
    LAS float* red = (LAS float*)(F.lds + 9 * 1024 * 4);
    for (int i = F.tid; i < 9 * 1024; i += NTHR) { const float v = (i < 8192) ? F.in[1][i] : F.in[3][i - 8192]; cond[i] = v * sigmoidf_(v); }
    __syncthreads();
    const int col = F.tid & 127, kq = F.tid >> 7;
    for (int it = F.bid; it < DEPTH * 72; it += F.G) {
        const int l = it / 72, n = (it % 72) * 128 + col;
        const float* wp = F.in[4] + (size_t)l * DM * NMOD + n;
        float a[9];
#pragma unroll
        for (int i = 0; i < 9; ++i) a[i] = 0.f;
#pragma unroll 16
        for (int k = kq * 256; k < kq * 256 + 256; ++k) { const float w = wp[(size_t)k * NMOD];
#pragma unroll
            for (int i = 0; i < 9; ++i) a[i] += cond[i * 1024 + k] * w; }
        __syncthreads();
#pragma unroll
        for (int i = 0; i < 9; ++i) red[(kq * 9 + i) * 128 + col] = a[i];
        __syncthreads();
        if (kq == 0) { const float bb = F.in[5][(size_t)l * NMOD + n];
#pragma unroll
            for (int i = 0; i < 9; ++i) F.MOD[((size_t)l * 9 + i) * NMOD + n] = red[i * 128 + col] + red[(9 + i) * 128 + col] + red[(18 + i) * 128 + col] + red[(27 + i) * 128 + col] + bb; }
    }
    const int gt = F.bid * NTHR + F.tid;
    if (gt < 2048) { const int pos = gt >> 5, i = gt & 31; const float inv = exp2f(-(float)i * (13.287712379549449f / 32.0f)); const float ang = (float)pos * inv;
        float rev = ang * 0.15915494309189535f; rev -= rintf(rev);
        const float r = rev * 6.283185307179586f;
        F.ROPE[gt * 2] = __cosf(r); F.ROPE[gt * 2 + 1] = __sinf(r); }
    __syncthreads();
}

__device__ __forceinline__ void phase_norm(const Frame& F, const float* xl, const float* xc, const f16* x16, int l, int which, int r0, int nrows, int ci, int nc) {
    const float* nw = F.in[6] + ((size_t)l * 3 + which) * DM;
    const int gw = r0 + ci * 8 + F.wave, nw_ = nc * 8;
    for (int row = gw; row < nrows; row += nw_) {
        const bool lat = row < TL; const int mi = lat ? (row >> 12) : 8;
        const float* sh = F.MOD + ((size_t)l * 9 + mi) * NMOD + (3 * which) * DM; const float* sc = sh + DM;
        float v[2][8]; float ss = 0.f;
        if (x16) {
            const f16* xp = x16 + (size_t)row * DM;
#pragma unroll
            for (int j = 0; j < 2; ++j) { const f16x8 t = *(const f16x8*)(xp + j * 512 + F.lane * 8);
#pragma unroll
                for (int e = 0; e < 8; ++e) v[j][e] = (float)t[e]; }
        } else {
            const float* xp = lat ? xl + (size_t)row * DM : xc + (size_t)(row - TL) * DM;
#pragma unroll
            for (int j = 0; j < 2; ++j) { const f32x4 a = *(const f32x4*)(xp + j * 512 + F.lane * 8), b = *(const f32x4*)(xp + j * 512 + F.lane * 8 + 4);
#pragma unroll
                for (int e = 0; e < 4; ++e) { v[j][e] = a[e]; v[j][4 + e] = b[e]; } }
        }
#pragma unroll
        for (int j = 0; j < 2; ++j)
#pragma unroll
            for (int e = 0; e < 8; ++e) ss += v[j][e] * v[j][e];
        ss = wave_sum(ss);
        const float rstd = rsqrtf(ss * (1.0f / DM) + 1e-6f);
#pragma unroll
        for (int j = 0; j < 2; ++j) { const int k = j * 512 + F.lane * 8;
            float o[8];
#pragma unroll
            for (int q = 0; q < 2; ++q) { const f32x4 w = *(const f32x4*)(nw + k + 4 * q), s1 = *(const f32x4*)(sc + k + 4 * q), s0 = *(const f32x4*)(sh + k + 4 * q);
#pragma unroll
                for (int e = 0; e < 4; ++e) o[4 * q + e] = v[j][4 * q + e] * rstd * w[e] * (1.0f + s1[e]) + s0[e]; }
            u32x4 pk;
            if (true) { pk.x = pk_bf16(o[0], o[1]); pk.y = pk_bf16(o[2], o[3]); pk.z = pk_bf16(o[4], o[5]); pk.w = pk_bf16(o[6], o[7]); }
            else { pk.x = pk_f16(o[0], o[1]); pk.y = pk_f16(o[2], o[3]); pk.z = pk_f16(o[4], o[5]); pk.w = pk_f16(o[6], o[7]); }
            *(u32x4*)(F.H16 + (size_t)row * DM + k) = pk; }
    }
}

__device__ __forceinline__ void phase_qkprep(const Frame& F, int l, bool last, int ci, int nc) {
    const float* qnw = F.in[12] + l * 128; const float* knw = F.in[13] + l * 128;
    const int lane = F.lane, j = lane & 7, hd = lane >> 3;
    const float QS = 0.08838834764831845f * 1.4426950408889634f;
    float wq[16], wk[16];
#pragma unroll
    for (int e = 0; e < 16; ++e) { wq[e] = qnw[j * 16 + e] * QS; wk[e] = knw[j * 16 + e]; }
    const bool second = (j & 2) != 0;
    const int gw = ci * 8 + F.wave, nw_ = nc * 8;
    for (int row = gw; row < TT; row += nw_) {
        const bool lat = row < TL;
        float cs[16], sn[16];
        if (lat) { const int t = row & 4095, pos = (j < 4) ? (t >> 6) : (t & 63); const float* tp = F.ROPE + (pos * 32 + (j & 1) * 16) * 2;
#pragma unroll
            for (int q4 = 0; q4 < 8; ++q4) { const f32x4 v = *(const f32x4*)(tp + q4 * 4); cs[q4 * 2] = v[0]; sn[q4 * 2] = v[1]; cs[q4 * 2 + 1] = v[2]; sn[q4 * 2 + 1] = v[3]; } }
        else {
#pragma unroll
            for (int e = 0; e < 16; ++e) { cs[e] = 1.f; sn[e] = 0.f; } }
        f16* zp = F.Z + (size_t)row * ZLD;
#pragma unroll
        for (int pass = 0; pass < 2; ++pass) {
            if (pass == 0 && !lat && last) continue;
            if (pass == 1 && hd >= 2) continue;
            f16* p = (pass == 0 ? zp + Z_AQ : zp + Z_AK) + hd * 128 + j * 16;
            const f16x8 r0 = *(const f16x8*)p, r1 = *(const f16x8*)(p + 8);
            float x[16]; float ss = 0.f;
#pragma unroll
            for (int e = 0; e < 8; ++e) { x[e] = (float)r0[e]; x[8 + e] = (float)r1[e]; }
#pragma unroll
            for (int e = 0; e < 16; ++e) ss += x[e] * x[e];
            ss += __shfl_xor(ss, 1); ss += __shfl_xor(ss, 2); ss += __shfl_xor(ss, 4);
            const float rstd = rsqrtf(ss * (1.0f / 128.0f) + 1e-6f);
            float o[16];
#pragma unroll
            for (int e = 0; e < 16; ++e) { const float xn = x[e] * rstd * (pass == 0 ? wq[e] : wk[e]); const float pn = __shfl_xor(xn, 2);
                o[e] = second ? (pn * sn[e] + xn * cs[e]) : (xn * cs[e] - pn * sn[e]); }
            u32x4 w0, w1; w0.x = pk_f16(o[0], o[1]); w0.y = pk_f16(o[2], o[3]); w0.z = pk_f16(o[4], o[5]); w0.w = pk_f16(o[6], o[7]);
            w1.x = pk_f16(o[8], o[9]); w1.y = pk_f16(o[10], o[11]); w1.z = pk_f16(o[12], o[13]); w1.w = pk_f16(o[14], o[15]);
            *(u32x4*)p = w0; *(u32x4*)(p + 8) = w1;
        }
    }
}

constexpr int GL_RQ = 0;
constexpr int GL_AM = GL_RQ;
constexpr int GL_RK = GL_RQ + 64 * 136 * 2;
constexpr int GL_LR = GL_RK + 64 * 136 * 2;
constexpr int GL_QT = GL_LR + 64 * 16 * 4;
constexpr int GL_KH = GL_QT + 64 * 136 * 2;
constexpr int GL_KT = GL_KH + 64 * 136 * 2;
constexpr int GL_VT = GL_KT + 128 * 72 * 2;
constexpr int GL_ST = GL_VT + 128 * 72 * 2;
constexpr int GL_EB = GL_ST + 128 * 136 * 2;
constexpr int GL_PS = GL_EB + 512;
constexpr int GL_END = GL_PS + 2048;
static_assert(GL_END + 16 <= LDS_BYTES, "GLA LDS");

__device__ __forceinline__ void phase_gla(const Frame& F, int l, int gi, int ng) {
    LAS unsigned char* lds = F.lds;
    const int tid = F.tid, lane = F.lane, w = F.wave, r32 = lane & 31, hh = lane >> 5;
    for (int item = gi; item < 128; item += ng) {
        const int b = item & 7, idx = item >> 3, h = idx >> 2, dir = (idx >> 1) & 1, sl = idx & 1;
        const float* gwp = (dir ? F.in[17] : F.in[15]) + (size_t)l * 16 * 512 + h * 128;
        const float* gbp = (dir ? F.in[18] : F.in[16]) + (size_t)l * 512 + h * 128;
        f16* Oout = dir ? F.OB : F.H16;
        const int d = tid & 127, tg = tid >> 7;
        f16x8 gwf;
#pragma unroll
        for (int j = 0; j < 8; ++j) gwf[j] = (f16)gwp[(hh * 8 + j) * 512 + (w & 3) * 32 + r32];
        const float gbv = gbp[(w & 3) * 32 + r32];
        const int li = tid >> 3, ls = tid & 7;
        const int vi = tid & 63, vs = tid >> 6;
        const int it = w >> 2, et = w & 3;
        const int dt = w >> 1, e2 = (w & 1) * 2;
        f32x16 Sacc[2];
#pragma unroll
        for (int q = 0; q < 2; ++q)
#pragma unroll
            for (int e = 0; e < 16; ++e) Sacc[q][e] = 0.f;
        __syncthreads();
        for (int i = tid; i < 128 * 136 / 2; i += NTHR) ((LAS unsigned*)(lds + GL_ST))[i] = 0u;
        u32x4 pq0, pq1, pk0, pk1, pv0, pv1; f32x2 pg;
        auto chunk_base = [&](int s) -> int { return (s < 4) ? (TL + b * CTXL + (dir ? 3 - s : s) * 64) : (b * SEQ + (dir ? 63 - (s - 4) : (s - 4)) * 64); };
#define GLA_LOAD(s) do { const int _row = chunk_base(s) + (dir ? 63 - li : li); const f16* _zp = F.Z + (size_t)_row * ZLD; \
            pq0 = *(const u32x4*)(_zp + Z_GQ + h * 128 + ls * 16); pq1 = *(const u32x4*)(_zp + Z_GQ + h * 128 + ls * 16 + 8); \
            pk0 = *(const u32x4*)(_zp + Z_GK + h * 128 + ls * 16); pk1 = *(const u32x4*)(_zp + Z_GK + h * 128 + ls * 16 + 8); \
            { const f16* _vp = F.Z + (size_t)(chunk_base(s) + (dir ? 63 - vi : vi)) * ZLD + Z_GV + h * 256 + sl * 128 + vs * 16; pv0 = *(const u32x4*)_vp; pv1 = *(const u32x4*)(_vp + 8); } \
            pg = *(const f32x2*)(F.GLR + (size_t)_row * 32 + dir * 16 + ls * 2); } while (0)
        GLA_LOAD(0);
        for (int s = 0; s < 68; ++s) {
            *(LAS u32x4*)(lds + GL_RQ + (li * 136 + ls * 16) * 2) = pq0; *(LAS u32x4*)(lds + GL_RQ + (li * 136 + ls * 16 + 8) * 2) = pq1;
            *(LAS u32x4*)(lds + GL_RK + (li * 136 + ls * 16) * 2) = pk0; *(LAS u32x4*)(lds + GL_RK + (li * 136 + ls * 16 + 8) * 2) = pk1;
            *(LAS unsigned*)(lds + GL_LR + (li * 16 + ls * 2) * 2) = pk_f16(pg.x, pg.y);
            { const f16x8 va = __builtin_bit_cast(f16x8, pv0), vb = __builtin_bit_cast(f16x8, pv1);
#pragma unroll
              for (int e = 0; e < 8; e += 2) { const unsigned pa = pk_bf16((float)va[e], (float)va[e + 1]), pb = pk_bf16((float)vb[e], (float)vb[e + 1]);
                  *(LAS unsigned short*)(lds + GL_VT + ((vs * 16 + e) * 72 + vi) * 2) = (unsigned short)(pa & 0xffffu);
                  *(LAS unsigned short*)(lds + GL_VT + ((vs * 16 + e + 1) * 72 + vi) * 2) = (unsigned short)(pa >> 16);
                  *(LAS unsigned short*)(lds + GL_VT + ((vs * 16 + 8 + e) * 72 + vi) * 2) = (unsigned short)(pb & 0xffffu);
                  *(LAS unsigned short*)(lds + GL_VT + ((vs * 16 + 8 + e + 1) * 72 + vi) * 2) = (unsigned short)(pb >> 16); } }
            __syncthreads();
            if (s + 1 < 68) GLA_LOAD(s + 1);
            { const f16x8 ga = *(const LAS f16x8*)(lds + GL_LR + ((w >> 2) * 32 + r32) * 32 + hh * 16);
              f32x16 la;
#pragma unroll
              for (int e = 0; e < 16; ++e) la[e] = 0.f;
              la = __builtin_amdgcn_mfma_f32_32x32x16_f16(ga, gwf, la, 0, 0, 0);
#pragma unroll
              for (int e = 0; e < 16; ++e) { const int i = (w >> 2) * 32 + (e & 3) + 8 * (e >> 2) + 4 * hh; const float lg = la[e] + gbv;
                  ((LAS float*)(lds + GL_QT))[i * 128 + (w & 3) * 32 + r32] = (fminf(lg, 0.f) * 1.4426950408889634f - __builtin_amdgcn_logf(1.0f + __builtin_amdgcn_exp2f(fabsf(lg) * -1.4426950408889634f))) * (1.0f / 16.0f); } }
            __syncthreads();
            float bl[16]; float cum = 0.f;
#pragma unroll
            for (int ii = 0; ii < 16; ++ii) { cum += ((const LAS float*)(lds + GL_QT))[(tg * 16 + ii) * 128 + d]; bl[ii] = cum; }
            ((LAS float*)(lds + GL_PS))[tg * 128 + d] = cum;
            __syncthreads();
            float off = 0.f, tot = 0.f;
#pragma unroll
            for (int t2 = 0; t2 < 4; ++t2) { const float pv2 = ((LAS float*)(lds + GL_PS))[t2 * 128 + d]; tot += pv2; if (t2 < tg) off += pv2; }
            const float etot = __builtin_amdgcn_exp2f(tot);
            if (tg == 0) ((LAS float*)(lds + GL_EB))[d] = etot;
            { unsigned ktp[8];
#pragma unroll
              for (int ii = 0; ii < 16; ii += 2) {
                  float kt2[2];
#pragma unroll
                  for (int e = 0; e < 2; ++e) { const int i = tg * 16 + ii + e; const float bi = off + bl[ii + e];
                      const float qv = (float)*(const LAS f16*)(lds + GL_RQ + (i * 136 + d) * 2), kv = (float)*(const LAS f16*)(lds + GL_RK + (i * 136 + d) * 2);
                      const float qt = qv * 0.08838834764831845f * __builtin_amdgcn_exp2f(bi), kh = kv * __builtin_amdgcn_exp2f(-bi); kt2[e] = kh * etot;
                      *(LAS unsigned short*)(lds + GL_QT + (i * 136 + d) * 2) = (unsigned short)(pk_bf16(qt, qt) & 0xffffu);
                      *(LAS unsigned short*)(lds + GL_KH + (i * 136 + d) * 2) = (unsigned short)(pk_bf16(kh, kh) & 0xffffu); }
                  ktp[ii >> 1] = pk_bf16(kt2[0], kt2[1]); }
              *(LAS u32x4*)(lds + GL_KT + (d * 72 + tg * 16) * 2) = (u32x4){ktp[0], ktp[1], ktp[2], ktp[3]};
              *(LAS u32x4*)(lds + GL_KT + (d * 72 + tg * 16 + 8) * 2) = (u32x4){ktp[4], ktp[5], ktp[6], ktp[7]}; }
            __syncthreads();
            f32x16 oacc;
#pragma unroll
            for (int e = 0; e < 16; ++e) oacc[e] = 0.f;
#pragma unroll
            for (int ks = 0; ks < 8; ++ks) {
                const s16x8 a = *(const LAS s16x8*)(lds + GL_QT + ((it * 32 + r32) * 136 + ks * 16 + hh * 8) * 2);
                const s16x8 bb = *(const LAS s16x8*)(lds + GL_ST + ((et * 32 + r32) * 136 + ks * 16 + hh * 8) * 2);
                oacc = __builtin_amdgcn_mfma_f32_32x32x16_bf16(a, bb, oacc, 0, 0, 0); }
            if (w >= 4 && w < 7) {
                const int jt = (w == 6) ? 1 : 0, it2 = (w == 4) ? 0 : 1;
                f32x16 aacc;
#pragma unroll
                for (int e = 0; e < 16; ++e) aacc[e] = 0.f;
#pragma unroll
                for (int ks = 0; ks < 8; ++ks) {
                    const s16x8 a = *(const LAS s16x8*)(lds + GL_KH + ((jt * 32 + r32) * 136 + ks * 16 + hh * 8) * 2);
                    const s16x8 bb = *(const LAS s16x8*)(lds + GL_QT + ((it2 * 32 + r32) * 136 + ks * 16 + hh * 8) * 2);
                    aacc = __builtin_amdgcn_mfma_f32_32x32x16_bf16(a, bb, aacc, 0, 0, 0); }
                const int i = it2 * 32 + r32;
#pragma unroll
                for (int g4 = 0; g4 < 4; ++g4) { const int j0 = jt * 32 + g4 * 8 + hh * 4; float v4[4];
#pragma unroll
                    for (int e = 0; e < 4; ++e) v4[e] = (j0 + e <= i) ? aacc[g4 * 4 + e] : 0.f;
                    *(LAS u32x2*)(lds + GL_AM + (i * 72 + j0) * 2) = (u32x2){pk_bf16(v4[0], v4[1]), pk_bf16(v4[2], v4[3])}; }
            } else if (w == 7) {
#pragma unroll
                for (int q = 0; q < 4; ++q) { const int ci = lane + q * 64, i = ci >> 3, j0 = 32 + (ci & 7) * 4; *(LAS u32x2*)(lds + GL_AM + (i * 72 + j0) * 2) = (u32x2){0u, 0u}; }
            }
            __syncthreads();
#pragma unroll
            for (int ks = 0; ks < 4; ++ks) {
                const s16x8 a = *(const LAS s16x8*)(lds + GL_AM + ((it * 32 + r32) * 72 + ks * 16 + hh * 8) * 2);
                const s16x8 bb = *(const LAS s16x8*)(lds + GL_VT + ((et * 32 + r32) * 72 + ks * 16 + hh * 8) * 2);
                oacc = __builtin_amdgcn_mfma_f32_32x32x16_bf16(a, bb, oacc, 0, 0, 0); }
            { const int cb = chunk_base(s), i0 = it * 32 + 4 * hh; const long rs = dir ? -(long)DM : (long)DM;
              f16* ob = Oout + (size_t)(cb + (dir ? 63 - i0 : i0)) * DM + h * 256 + sl * 128 + et * 32 + r32;
#pragma unroll
              for (int e = 0; e < 16; ++e) ob[((e & 3) + 8 * (e >> 2)) * rs] = (f16)oacc[e]; }
#pragma unroll
            for (int q = 0; q < 2; ++q) {
#pragma unroll
                for (int g4 = 0; g4 < 4; ++g4) { const f32x4 ev = *(const LAS f32x4*)(lds + GL_EB + (dt * 32 + g4 * 8 + hh * 4) * 4);
#pragma unroll
                    for (int e = 0; e < 4; ++e) Sacc[q][g4 * 4 + e] *= ev[e]; }
#pragma unroll
                for (int ks = 0; ks < 4; ++ks) {
                    const s16x8 a = *(const LAS s16x8*)(lds + GL_KT + ((dt * 32 + r32) * 72 + ks * 16 + hh * 8) * 2);
                    const s16x8 bb = *(const LAS s16x8*)(lds + GL_VT + (((e2 + q) * 32 + r32) * 72 + ks * 16 + hh * 8) * 2);
                    Sacc[q] = __builtin_amdgcn_mfma_f32_32x32x16_bf16(a, bb, Sacc[q], 0, 0, 0); }
#pragma unroll
                for (int g4 = 0; g4 < 4; ++g4)
                    *(LAS u32x2*)(lds + GL_ST + (((e2 + q) * 32 + r32) * 136 + dt * 32 + g4 * 8 + hh * 4) * 2) = (u32x2){pk_bf16(Sacc[q][g4 * 4], Sacc[q][g4 * 4 + 1]), pk_bf16(Sacc[q][g4 * 4 + 2], Sacc[q][g4 * 4 + 3])};
            }
            __syncthreads();
        }
#undef GLA_LOAD
    }
}

__device__ __forceinline__ void phase_glacomb(const Frame& F, int l, int nrows) {
    const float* gnw = F.in[19] + l * 256;
    float wv[16];
#pragma unroll
    for (int e = 0; e < 16; ++e) wv[e] = gnw[(F.lane & 15) * 16 + e];
    const int gw = F.bid * 8 + F.wave, nw_ = F.G * 8;
    for (int row = gw; row < nrows; row += nw_) {
        const size_t o = (size_t)row * DM + F.lane * 16;
        const f16x8 a0 = *(const f16x8*)(F.H16 + o), a1 = *(const f16x8*)(F.H16 + o + 8), b0 = *(const f16x8*)(F.OB + o), b1 = *(const f16x8*)(F.OB + o + 8);
        f16* gp = F.Z + (size_t)row * ZLD + Z_GR + F.lane * 16;
        const f16x8 r0 = *(const f16x8*)gp, r1 = *(const f16x8*)(gp + 8);
        float v[16], r[16]; float ss = 0.f;
#pragma unroll
        for (int e = 0; e < 8; ++e) { v[e] = (float)a0[e] + (float)b0[e]; v[8 + e] = (float)a1[e] + (float)b1[e]; r[e] = (float)r0[e]; r[8 + e] = (float)r1[e]; }
#pragma unroll
        for (int e = 0; e < 16; ++e) ss += v[e] * v[e];
        ss += __shfl_xor(ss, 1); ss += __shfl_xor(ss, 2); ss += __shfl_xor(ss, 4); ss += __shfl_xor(ss, 8);
        const float rstd = rsqrtf(ss * (1.0f / 256.0f) + 1e-6f);
        float y[16];
#pragma unroll
        for (int e = 0; e < 16; ++e) y[e] = v[e] * rstd * wv[e] * r[e] * sigmoidf_(r[e]);
        u32x4 w0, w1; w0.x = pk_f16(y[0], y[1]); w0.y = pk_f16(y[2], y[3]); w0.z = pk_f16(y[4], y[5]); w0.w = pk_f16(y[6], y[7]);
        w1.x = pk_f16(y[8], y[9]); w1.y = pk_f16(y[10], y[11]); w1.z = pk_f16(y[12], y[13]); w1.w = pk_f16(y[14], y[15]);
        *(u32x4*)gp = w0; *(u32x4*)(gp + 8) = w1;
    }
}

constexpr int AT_K = 0;
constexpr int AT_V = AT_K + 64 * 136 * 2;
constexpr int AT_BUF = AT_V + 128 * 72 * 2;
constexpr int AT_P = 2 * AT_BUF;
constexpr int AT_END = AT_P + 8 * 32 * 72 * 2;
static_assert(AT_END <= LDS_BYTES, "attn LDS");

__device__ __forceinline__ void phase_attn(const Frame& F, int l, bool last, int ai, int na) {
    LAS unsigned char* lds = F.lds;
    const int tid = F.tid, lane = F.lane, w = F.wave, r32 = lane & 31, hh = lane >> 5;
    const int nitems = last ? 1024 : 1088;
    const float* sinkp = F.in[14] + l * 8;
    const int kkey = tid >> 3, kseg = (tid & 7) * 16;
    const int vkp = tid & 31, vdg = tid >> 5;
    LAS unsigned char* Pw = lds + AT_P + w * (32 * 72 * 2);
    for (int item = ai; item < nitems; item += na) {
        int b, qb, hk, hp; bool isctx;
        if (item < 1024) { isctx = false; b = item & 7; const int r = item >> 3; hk = r & 1; hp = (r >> 1) & 1; qb = r >> 2; }
        else { isctx = true; const int r = item - 1024; b = r & 7; hk = (r >> 3) & 1; hp = (r >> 4) & 1; qb = r >> 5; }
        const int hq = hk * 4 + hp * 2 + (w >> 2);
        const int qrow0 = (isctx ? TL + b * CTXL : b * SEQ) + qb * 128 + (w & 3) * 32;
        f16x8 qf[8];
        { const f16* qp = F.Z + (size_t)(qrow0 + r32) * ZLD + Z_AQ + hq * 128 + hh * 8;
#pragma unroll
          for (int s = 0; s < 8; ++s) qf[s] = *(const f16x8*)(qp + s * 16); }
        const float sk = sinkp[hq] * 1.4426950408889634f;
        float mrun = sk, lrun = 1.0f;
        f32x16 oacc[4];
#pragma unroll
        for (int dt = 0; dt < 4; ++dt)
#pragma unroll
            for (int e = 0; e < 16; ++e) oacc[dt][e] = 0.f;
        int wlo = 0, nwin = 0;
        if (!isctx) { const int lo = (qb == 0) ? 0 : qb * 128 - 128, hi = (qb == 31) ? SEQ : qb * 128 + 256; wlo = lo; nwin = (hi - lo) >> 6; }
        const int ntile = nwin + 4;
        const int qpos = qb * 128 + (w & 3) * 32 + r32;
        u32x4 k0, k1, v0, v1;
#define AT_LOAD(t) do { int _kr0; if ((t) < nwin) _kr0 = b * SEQ + wlo + (t) * 64; else _kr0 = TL + b * CTXL + ((t) - nwin) * 64; \
            const f16* _kp = F.Z + (size_t)(_kr0 + kkey) * ZLD + Z_AK + hk * 128 + kseg; k0 = *(const u32x4*)_kp; k1 = *(const u32x4*)(_kp + 8); \
            const f16* _vp = F.Z + (size_t)(_kr0 + 2 * vkp) * ZLD + Z_AV + hk * 128 + vdg * 8; v0 = *(const u32x4*)_vp; v1 = *(const u32x4*)(_vp + ZLD); } while (0)
        AT_LOAD(0);
#define AT_STORE(bo) do { *(LAS u32x4*)(lds + (bo) + AT_K + (kkey * 136 + kseg) * 2) = k0; *(LAS u32x4*)(lds + (bo) + AT_K + (kkey * 136 + kseg + 8) * 2) = k1; \
            const unsigned a0[4] = {v0.x, v0.y, v0.z, v0.w}, a1[4] = {v1.x, v1.y, v1.z, v1.w}; \
            _Pragma("unroll") for (int e = 0; e < 4; ++e) { \
                const unsigned lo = (a0[e] & 0xffffu) | (a1[e] << 16), hi = (a0[e] >> 16) | (a1[e] & 0xffff0000u); \
                *(LAS unsigned*)(lds + (bo) + AT_V + ((vdg * 8 + 2 * e) * 72 + 2 * vkp) * 2) = lo; \
                *(LAS unsigned*)(lds + (bo) + AT_V + ((vdg * 8 + 2 * e + 1) * 72 + 2 * vkp) * 2) = hi; } } while (0)
        __syncthreads();
        AT_STORE(0);
        if (ntile > 1) AT_LOAD(1);
        for (int t = 0; t < ntile; ++t) {
            const int bo = (t & 1) * AT_BUF;
            __syncthreads();
            if (t + 1 < ntile) { AT_STORE(AT_BUF - bo); if (t + 2 < ntile) AT_LOAD(t + 2); }
            const int kpos0 = wlo + t * 64, q0w = qb * 128 + (w & 3) * 32;
            const bool win = (t < nwin) && !(kpos0 <= q0w + 65 && kpos0 >= q0w - 97);
            if ((t < nwin) && (kpos0 > q0w + 159 || kpos0 < q0w - 191)) continue;
            f32x16 sacc[2];
#pragma unroll
            for (int kt = 0; kt < 2; ++kt) {
#pragma unroll
                for (int e = 0; e < 16; ++e) sacc[kt][e] = 0.f;
#pragma unroll
                for (int s = 0; s < 8; ++s) { const f16x8 a = *(const LAS f16x8*)(lds + bo + AT_K + ((kt * 32 + r32) * 136 + s * 16 + hh * 8) * 2);
                    sacc[kt] = __builtin_amdgcn_mfma_f32_32x32x16_f16(a, qf[s], sacc[kt], 0, 0, 0); } }
            float mx = -1e30f;
#pragma unroll
            for (int kt = 0; kt < 2; ++kt)
#pragma unroll
                for (int e = 0; e < 16; ++e) {
                    if (win) { const int kp = kpos0 + kt * 32 + (e & 3) + 8 * (e >> 2) + 4 * hh; const int dd = kp - qpos; if (dd > 128 || dd < -128) sacc[kt][e] = -1e30f; }
                    mx = fmaxf(mx, sacc[kt][e]); }
            mx = fmaxf(mx, __shfl_xor(mx, 32));
            const bool upd = mx > mrun + 8.0f;
            const bool anyupd = __builtin_amdgcn_ballot_w64(upd) != 0ull;
            const float mnew = upd ? mx : mrun;
            float rs = 0.f;
#pragma unroll
            for (int kt = 0; kt < 2; ++kt)
#pragma unroll
                for (int g4 = 0; g4 < 4; ++g4) { float pv4[4];
#pragma unroll
                    for (int e = 0; e < 4; ++e) { pv4[e] = __builtin_amdgcn_exp2f(sacc[kt][g4 * 4 + e] - mnew); rs += pv4[e]; }
                    *(LAS u32x2*)(Pw + (r32 * 72 + kt * 32 + g4 * 8 + hh * 4) * 2) = (u32x2){pk_f16(pv4[0], pv4[1]), pk_f16(pv4[2], pv4[3])}; }
            rs += __shfl_xor(rs, 32);
            if (anyupd) { const float alpha = __builtin_amdgcn_exp2f(mrun - mnew); lrun *= alpha;
#pragma unroll
                for (int dt = 0; dt < 4; ++dt)
#pragma unroll
                    for (int e = 0; e < 16; ++e) oacc[dt][e] *= alpha; }
            lrun += rs; mrun = mnew;
            asm volatile("s_waitcnt lgkmcnt(0)" ::: "memory");
#pragma unroll
            for (int s = 0; s < 4; ++s) { const f16x8 pb = *(const LAS f16x8*)(Pw + (r32 * 72 + s * 16 + hh * 8) * 2);
#pragma unroll
                for (int dt = 0; dt < 4; ++dt) { const f16x8 a = *(const LAS f16x8*)(lds + bo + AT_V + ((dt * 32 + r32) * 72 + s * 16 + hh * 8) * 2);
                    oacc[dt] = __builtin_amdgcn_mfma_f32_32x32x16_f16(a, pb, oacc[dt], 0, 0, 0); } }
        }
#undef AT_LOAD
#undef AT_STORE
        const float inv = 1.0f / lrun;
        f16* op = F.Z + (size_t)(qrow0 + r32) * ZLD + Z_AQ + hq * 128;
#pragma unroll
        for (int dt = 0; dt < 4; ++dt)
#pragma unroll
            for (int g4 = 0; g4 < 4; ++g4)
                *(u32x2*)(op + dt * 32 + g4 * 8 + hh * 4) = (u32x2){pk_f16(oacc[dt][g4 * 4] * inv, oacc[dt][g4 * 4 + 1] * inv), pk_f16(oacc[dt][g4 * 4 + 2] * inv, oacc[dt][g4 * 4 + 3] * inv)};
    }
    __syncthreads();
}

#define XB_TMO      128
#define XB_XCNT(j)  (256  + 64 * (j))
#define XB_XSUB(j)  (1280 + 64 * (j))
#define XB_XGEN(j)  (2304 + 64 * (j))
#define XB_TOP      3328
#define XB_TOPGEN   3392
#define XCD_BAR_WORDS 3456
#define XB_SPIN_CAP (1u << 18)

__device__ __forceinline__ unsigned xb_ld(unsigned* p)              { return __hip_atomic_load(p, __ATOMIC_RELAXED, __HIP_MEMORY_SCOPE_AGENT); }
__device__ __forceinline__ unsigned xb_add(unsigned* p, unsigned v) { return __hip_atomic_fetch_add(p, v, __ATOMIC_RELAXED, __HIP_MEMORY_SCOPE_AGENT); }
__device__ __forceinline__ unsigned xb_xcc_id() { return (unsigned)__builtin_amdgcn_s_getreg((3 << 11) | 20) & 0xFu; }
#define XB_SPIN(cond, bar) do { unsigned _sp = 0; while (cond) { __builtin_amdgcn_s_sleep(1); \
    if ((++_sp & 255u) == 0u) { if (xb_ld(&(bar)[XB_TMO])) break; if (_sp > XB_SPIN_CAP) { atomicAdd(&(bar)[XB_TMO], 1u); break; } } } } while (0)

struct XcdBarrier {
    unsigned* bar; unsigned x;
    volatile LAS unsigned* st;
};

__device__ __forceinline__ XcdBarrier xcd_barrier_post(unsigned* bar, volatile LAS unsigned* st) {
    XcdBarrier b; b.bar = bar; b.x = xb_xcc_id(); b.st = st;
    if (threadIdx.x == 0) (void)xb_add(&bar[XB_XCNT(b.x)], 1u);
    return b;
}
__device__ __forceinline__ void xcd_barrier_complete(unsigned* bar, unsigned x, unsigned& nloc, unsigned& nx) {
    const unsigned G = gridDim.x * gridDim.y * gridDim.z;
    unsigned sum, cnt, mine, sp = 0u;
    for (;;) {
        sum = 0u; cnt = 0u; mine = 0u;
#pragma unroll
        for (unsigned j = 0; j < 16; ++j) { const unsigned c = xb_ld(&bar[XB_XCNT(j)]); sum += c; cnt += (c > 0u) ? 1u : 0u; mine = (j == x) ? c : mine; }
        if (sum == G) break;
        __builtin_amdgcn_s_sleep(1);
        if ((++sp & 255u) == 0u) { if (xb_ld(&bar[XB_TMO])) break; if (sp > XB_SPIN_CAP) { atomicAdd(&bar[XB_TMO], 1u); break; } }
    }
    nloc = mine > 0u ? mine : 1u; nx = cnt > 0u ? cnt : 1u;
}

__device__ __forceinline__ void xcd_barrier(const XcdBarrier& b) {
    asm volatile("s_waitcnt vmcnt(0)" ::: "memory");
    __syncthreads();
    if (threadIdx.x == 0) {
        unsigned* bar = b.bar;
        __builtin_amdgcn_s_waitcnt(0);
        unsigned nloc = b.st[0], nx = b.st[1];
        if (nloc == 0u) { xcd_barrier_complete(bar, b.x, nloc, nx); b.st[0] = nloc; b.st[1] = nx; }
        const unsigned old = xb_add(&bar[XB_XSUB(b.x)], 1u);
        const unsigned gen = old / nloc;
        if (old + 1u == (gen + 1u) * nloc) {
            __builtin_amdgcn_fence(__ATOMIC_RELEASE, "agent");
            asm volatile("s_waitcnt vmcnt(0)" ::: "memory");
            const unsigned og = xb_add(&bar[XB_TOP], 1u);
            const unsigned tg = og / nx;
            if (og + 1u == (tg + 1u) * nx) xb_add(&bar[XB_TOPGEN], 1u);
            else XB_SPIN(xb_ld(&bar[XB_TOPGEN]) == tg, bar);
            __builtin_amdgcn_fence(__ATOMIC_ACQUIRE, "agent");
            xb_add(&bar[XB_XGEN(b.x)], 1u);
            asm volatile("s_waitcnt vmcnt(0)" ::: "memory");
        } else {
            XB_SPIN(xb_ld(&bar[XB_XGEN(b.x)]) == gen, bar);
            __builtin_amdgcn_fence(__ATOMIC_ACQUIRE, "agent");
            asm volatile("s_waitcnt vmcnt(0)" ::: "memory");
        }
    }
    __syncthreads();
}


#define gsync(bar_, epoch_) xcd_barrier(xbar)
__device__ __forceinline__ void sub_barrier(unsigned* word, unsigned target) {
    asm volatile("s_waitcnt vmcnt(0) lgkmcnt(0)" ::: "memory");
    __syncthreads();
    if (threadIdx.x == 0) {
        __builtin_amdgcn_fence(__ATOMIC_RELEASE, "agent");
        asm volatile("s_waitcnt vmcnt(0)" ::: "memory");
        (void)__hip_atomic_fetch_add(word, 1u, __ATOMIC_RELAXED, __HIP_MEMORY_SCOPE_AGENT);
        unsigned sp = 0;
        while (__hip_atomic_load(word, __ATOMIC_RELAXED, __HIP_MEMORY_SCOPE_AGENT) < target) { __builtin_amdgcn_s_sleep(2); if (++sp > (1u << 22)) break; }
        __builtin_amdgcn_fence(__ATOMIC_ACQUIRE, "agent");
        asm volatile("s_waitcnt vmcnt(0)" ::: "memory");
    }
    __syncthreads();
}
__device__ __forceinline__ void sub_wait(unsigned* word, unsigned target) {
    if (threadIdx.x == 0) {
        unsigned sp = 0;
        while (__hip_atomic_load(word, __ATOMIC_RELAXED, __HIP_MEMORY_SCOPE_AGENT) < target) { __builtin_amdgcn_s_sleep(2); if (++sp > (1u << 22)) break; }
        __builtin_amdgcn_fence(__ATOMIC_ACQUIRE, "agent");
        asm volatile("s_waitcnt vmcnt(0)" ::: "memory");
    }
    __syncthreads();
}
typedef const __attribute__((address_space(4))) Params* KParamsPtr;
__device__ __forceinline__ Frame mkframe(LAS unsigned char* lds) {
    KParamsPtr kp = (KParamsPtr)__builtin_amdgcn_kernarg_segment_ptr();
    asm volatile("" : "+s"(kp));
    Frame F;
    int tid_ = threadIdx.x, bid_ = blockIdx.x, g_ = gridDim.x;
    asm volatile("" : "+v"(tid_), "+s"(bid_), "+s"(g_));
    F.lds = lds; F.tid = tid_; F.lane = F.tid & 63; F.wave = __builtin_amdgcn_readfirstlane(F.tid >> 6); F.G = g_; F.bid = bid_;
#pragma unroll
    for (int i = 0; i < 23; ++i) F.in[i] = kp->in[i];
    F.out = kp->out; unsigned char* ws = kp->ws; F.ws = ws;
    F.MOD = (float*)(ws + WS_MOD); F.ROPE = (float*)(ws + WS_ROPE); F.W13T = (f16*)(ws + WS_WA); F.W2T = (f16*)(ws + WS_WA + WA_W2);
    F.WINT = (f16*)(ws + WS_WB); F.WBAT = (f16*)(ws + WS_WB + WB_BA); F.WBGT = (f16*)(ws + WS_WB + WB_BG); F.WOUTT = (f16*)(ws + WS_WB + WB_OUT);
    F.XH = (f16*)(ws + WS_XH); F.H16 = (f16*)(ws + WS_H16); F.OB = (f16*)(ws + WS_OB); F.GLR = (float*)(ws + WS_GLR); F.Z = (f16*)(ws + WS_Z);
    return F;
}
#ifndef PMASK
#define PMASK 0xffff
#endif
#ifndef MIX_TEST
#define MIX_TEST 0
#endif
#ifndef STOP_AT
#define STOP_AT 99
#endif
__global__ void __launch_bounds__(NTHR, 2) mega(Params p) {
    extern __shared__ __attribute__((aligned(16))) unsigned char smem[];
    cg::grid_group grid = cg::this_grid();
    LAS unsigned char* lds = (LAS unsigned char*)smem;
    volatile LAS unsigned* xst = (volatile LAS unsigned*)(lds + LDS_BYTES - 16);
    if (threadIdx.x < 4) xst[threadIdx.x] = 0u;
    __syncthreads();
    const XcdBarrier xbar = xcd_barrier_post((unsigned*)(p.ws + WS_BAR), xst);
    grid.sync();
    if (PMASK & 1) { const Frame F = mkframe(lds); phase_mod(F); }
    gsync(bar, epoch);
    for (int l = 0; l < DEPTH; ++l) {
        const bool last = (l == DEPTH - 1);
        const int mrows = last ? TL : TT;
        if (PMASK & 2) { const Frame F = mkframe(lds);
            conv_weight(F, F.in[7] + (size_t)l * DM * 2 * DFF, F.W13T, DM, 2 * DFF, 2 * DFF, 1, F.bid, F.G);
            conv_weight(F, F.in[8] + (size_t)l * DFF * DM, F.W2T, DFF, DM, DM, 3, F.bid, F.G);
            phase_norm(F, F.in[0], F.in[2], (l == 0) ? (const f16*)nullptr : F.XH, l, 0, (l == 0) ? 0 : TL, TT, F.bid, F.G); }
        gsync(bar, epoch);
        if (PMASK & 4) { const Frame F = mkframe(lds); pg8::StaticOrder S; Gemm g{F.H16, F.W13T, TT, 2 * DFF, DM, DM, DM}; S.init(g.M, g.N, F.G, F.bid); EpiSwiglu E{F.Z}; pg8::gemm_phase(F.lds, g, S, E); }
        gsync(bar, epoch);
        if (PMASK & 8) { const Frame F = mkframe(lds); pg8::StaticOrder S; Gemm g{F.Z, F.W2T, TT, DM, DFF, DFF, DFF}; S.init_tail(TL, g.M, g.N, F.G, F.bid);
            EpiResid E{F.in[0], F.in[2], F.XH, F.out, F.MOD + (size_t)l * 9 * NMOD + 2 * DM, 0.5f, l == 0, false};
            unsigned* aw = (unsigned*)(F.ws + WS_BAR + 15360 + 64 * (2 * l)); pg8::gemm_phase(F.lds, g, S, E, aw, 2);
            const int extra = (TL / 256) * 4 + ((TT - TL) / 128) * 4 - 2 * F.G;
            if (extra >= 0 && extra < F.G && F.bid >= extra) { const int ci = F.bid - extra, nc = F.G - extra;
                conv_weight(F, F.in[11] + (size_t)l * DM * INC, F.WINT, DM, INC, NIN, 2, ci, nc);
                conv_weight(F, F.in[20] + (size_t)l * DM * DM, F.WBAT, DM, DM, DM, 0, ci, nc);
                conv_weight(F, F.in[21] + (size_t)l * DM * DM, F.WBGT, DM, DM, DM, 0, ci, nc);
                conv_weight(F, F.in[22] + (size_t)l * DM * DM, F.WOUTT, DM, DM, DM, 3, ci, nc);
                sub_wait(aw, (unsigned)F.G);
                phase_norm(F, F.in[0], F.in[2], F.XH, l, 1, 0, TL, ci, nc); }
            else if (!(extra >= 0 && extra < F.G)) {
                conv_weight(F, F.in[11] + (size_t)l * DM * INC, F.WINT, DM, INC, NIN, 2, F.bid, F.G);
                conv_weight(F, F.in[20] + (size_t)l * DM * DM, F.WBAT, DM, DM, DM, 0, F.bid, F.G);
                conv_weight(F, F.in[21] + (size_t)l * DM * DM, F.WBGT, DM, DM, DM, 0, F.bid, F.G);
                conv_weight(F, F.in[22] + (size_t)l * DM * DM, F.WOUTT, DM, DM, DM, 3, F.bid, F.G);
                sub_wait(aw, (unsigned)F.G); phase_norm(F, F.in[0], F.in[2], F.XH, l, 1, 0, TL, F.bid, F.G); } }
        gsync(bar, epoch);
        if (STOP_AT == 3) return;
        if (PMASK & 2) { const Frame F = mkframe(lds);
            phase_norm(F, F.in[0], F.in[2], F.XH, l, 1, TL, TT, F.bid, F.G); }
        gsync(bar, epoch);
        if (PMASK & 16) { const Frame F = mkframe(lds); pg8::StaticOrder S; Gemm g{F.H16, F.WINT, TT, NIN, DM, DM, DM}; S.init(g.M, g.N, F.G, F.bid); EpiWin E{F.Z, F.GLR}; pg8::gemm_phase(F.lds, g, S, E); }
        gsync(bar, epoch);
        { const Frame F = mkframe(lds); const int sub = (F.bid & 7) + 8 * (F.bid >> 4), half = F.G >> 1;
          if (((F.bid >> 3) & 1) == 0) phase_gla(F, l, sub, half);
          else { phase_qkprep(F, l, last, sub, half); sub_barrier((unsigned*)(F.ws + WS_BAR + 14336 + 256 * l), (unsigned)half); phase_attn(F, l, last, sub, half); } }
        gsync(bar, epoch);
        { const Frame F = mkframe(lds); phase_glacomb(F, l, mrows); }
        gsync(bar, epoch);
        if ((PMASK & 512) && MIX_TEST != 2) { const Frame F = mkframe(lds); pg8::StaticOrder S; Gemm g{F.Z + Z_AQ, F.WBAT, mrows, DM, DM, ZLD, DM}; S.init_tail(TL, g.M, g.N, F.G, F.bid); EpiMerge<false> E{F.H16, F.Z + Z_GA}; pg8::gemm_phase(F.lds, g, S, E); }
        if ((PMASK & 512) && MIX_TEST != 1) { const Frame F = mkframe(lds); pg8::StaticOrder S; Gemm g{F.Z + Z_GR, F.WBGT, mrows, DM, DM, ZLD, DM}; S.init_tail(TL, g.M, g.N, F.G, F.bid); EpiMerge<(MIX_TEST != 2)> E{F.H16, F.Z + Z_GG}; pg8::gemm_phase(F.lds, g, S, E); }
        gsync(bar, epoch);
        if (PMASK & 1024) { const Frame F = mkframe(lds); pg8::StaticOrder S; Gemm g{F.H16, F.WOUTT, mrows, DM, DM, DM, DM}; S.init_tail(TL, g.M, g.N, F.G, F.bid);
            EpiResid E{F.in[0], F.in[2], F.XH, F.out, F.MOD + (size_t)l * 9 * NMOD + 5 * DM, 1.0f, false, false}; pg8::gemm_phase(F.lds, g, S, E);
            int extra = (TL / 256) * 4 + ((mrows - TL) / 128) * 4 - 2 * F.G; if (extra < 0 || extra >= F.G) extra = 0;
            if (F.bid >= extra) { const int ci = F.bid - extra, nc = F.G - extra;
                conv_weight(F, F.in[9] + (size_t)l * DM * 2 * DFF, F.W13T, DM, 2 * DFF, 2 * DFF, 1, ci, nc);
                conv_weight(F, F.in[10] + (size_t)l * DFF * DM, F.W2T, DFF, DM, DM, 3, ci, nc); } }
        gsync(bar, epoch);
        if (STOP_AT == 9) return;
        if (PMASK & 2) { const Frame F = mkframe(lds);
            phase_norm(F, F.in[0], F.in[2], F.XH, l, 2, 0, mrows, F.bid, F.G); }
        gsync(bar, epoch);
        if (PMASK & 4) { const Frame F = mkframe(lds); pg8::StaticOrder S; Gemm g{F.H16, F.W13T, mrows, 2 * DFF, DM, DM, DM}; S.init(g.M, g.N, F.G, F.bid); EpiSwiglu E{F.Z}; pg8::gemm_phase(F.lds, g, S, E); }
        gsync(bar, epoch);
        if (PMASK & 8) { const Frame F = mkframe(lds); pg8::StaticOrder S; Gemm g{F.Z, F.W2T, mrows, DM, DFF, DFF, DFF}; S.init_tail(TL, g.M, g.N, F.G, F.bid);
            EpiResid E{F.in[0], F.in[2], F.XH, F.out, F.MOD + (size_t)l * 9 * NMOD + 8 * DM, 0.5f, false, last};
            unsigned* aw = (unsigned*)(F.ws + WS_BAR + 15360 + 64 * (2 * l + 1)); pg8::gemm_phase(F.lds, g, S, E, last ? (unsigned*)nullptr : aw, 2);
            if (!last) { int extra = (TL / 256) * 4 + ((mrows - TL) / 128) * 4 - 2 * F.G; if (extra < 0 || extra >= F.G) extra = 0;
                if (F.bid >= extra) { sub_wait(aw, (unsigned)F.G); phase_norm(F, F.in[0], F.in[2], F.XH, l + 1, 0, 0, TL, F.bid - extra, F.G - extra); } } }
        gsync(bar, epoch);
    }
}

extern "C" void kernel_launch(void* const* d_in, const int* in_sizes, int n_in, void* d_out, int out_size, void* d_ws, size_t ws_size, hipStream_t stream) {
    static int grid = 0;
    if (grid == 0) {
        if (n_in != 23 || ws_size < WS_END) { fprintf(stderr, "kernel_launch: need 23 inputs and %zu bytes of workspace (got %d, %zu)\n", (size_t)WS_END, n_in, ws_size); grid = -1; return; }
        int dev = 0, cus = 0, per_cu = 0;
        hipGetDevice(&dev); hipDeviceGetAttribute(&cus, hipDeviceAttributeMultiprocessorCount, dev);
        if (hipFuncSetAttribute((const void*)mega, hipFuncAttributeMaxDynamicSharedMemorySize, LDS_BYTES) != hipSuccess) { fprintf(stderr, "kernel_launch: hipFuncSetAttribute failed\n"); grid = -1; return; }
        if (hipOccupancyMaxActiveBlocksPerMultiprocessor(&per_cu, (const void*)mega, NTHR, LDS_BYTES) != hipSuccess || per_cu < 1) { fprintf(stderr, "kernel_launch: occupancy query says %d\n", per_cu); per_cu = 1; }
        (void)hipGetLastError();
        grid = cus;
    }
    if (grid < 0) return;
    if (hipMemsetAsync((char*)d_ws + WS_BAR, 0, 16384, stream) != hipSuccess) { fprintf(stderr, "kernel_launch: memset failed\n"); return; }
    Params p{};
    for (int i = 0; i < 23; ++i) p.in[i] = (const float*)d_in[i];
    p.out = (float*)d_out; p.ws = (unsigned char*)d_ws;
    void* args[] = {&p};
    hipError_t e = hipLaunchCooperativeKernel((const void*)mega, dim3(grid), dim3(NTHR), args, LDS_BYTES, stream);
    if (e != hipSuccess) fprintf(stderr, "kernel_launch: cooperative launch failed: %s (grid %d)\n", hipGetErrorString(e), grid);
}
```

```cpp
#include <hip/hip_runtime.h>
#include <hip/hip_cooperative_groups.h>
#include <cstdio>
#include <cstdint>
namespace cg = cooperative_groups;

#define LAS __attribute__((address_space(3)))
typedef _Float16 f16;
typedef _Float16 f16x8 __attribute__((ext_vector_type(8)));
typedef _Float16 f16x4 __attribute__((ext_vector_type(4)));
typedef _Float16 f16x2 __attribute__((ext_vector_type(2)));
typedef short s16x8 __attribute__((ext_vector_type(8)));
typedef float f32x2 __attribute__((ext_vector_type(2)));
typedef float f32x4 __attribute__((ext_vector_type(4)));
typedef float f32x16 __attribute__((ext_vector_type(16)));
typedef unsigned u32x2 __attribute__((ext_vector_type(2)));
typedef unsigned u32x4 __attribute__((ext_vector_type(4)));

constexpr int DM = 1024, NB = 8, SEQ = 4096, DEPTH = 4, CTXL = 256, DFF = 2816;
constexpr int TL = NB * SEQ, TC = NB * CTXL, TT = TL + TC;
constexpr int NMOD = 9 * DM;
constexpr int INC = 6688;
constexpr int ZLD = 6656;
constexpr int Z_AK = 0, Z_AV = 256, Z_GK = 512, Z_GV = 1024, Z_AQ = 2048, Z_GQ = 3072, Z_GR = 3584, Z_GA = 4608, Z_GG = 5632;
constexpr int NIN = 6912;
constexpr int NTHR = 512;
constexpr int LDS_BYTES = 148480;

constexpr size_t WS_MOD = 0;
constexpr size_t WS_ROPE = WS_MOD + (size_t)DEPTH * 9 * NMOD * 4;
constexpr size_t WS_WA = WS_ROPE + 64 * 32 * 2 * 4;
constexpr size_t WA_W2 = (size_t)2 * DFF * DM * 2;
constexpr size_t WS_WB = WS_WA + WA_W2 + (size_t)DM * DFF * 2;
constexpr size_t WB_BA = (size_t)NIN * DM * 2, WB_BG = WB_BA + (size_t)DM * DM * 2, WB_OUT = WB_BG + (size_t)DM * DM * 2;
constexpr size_t WS_XH = WS_WB + WB_OUT + (size_t)DM * DM * 2;
constexpr size_t WS_H16 = WS_XH + (size_t)TT * DM * 2;
constexpr size_t WS_OB = WS_H16 + (size_t)TT * DM * 2;
constexpr size_t WS_GLR = WS_OB + (size_t)TT * DM * 2;
constexpr size_t WS_Z = WS_GLR + (size_t)TT * 32 * 4;
constexpr size_t WS_BAR = WS_Z + (size_t)TT * ZLD * 2;
constexpr size_t WS_END = WS_BAR + 16384;

struct Params {
    const float* in[23];
    float* out;
    unsigned char* ws;
};

__device__ __forceinline__ unsigned pk_f16(float a, float b) { f16x2 v; v.x = (f16)a; v.y = (f16)b; return __builtin_bit_cast(unsigned, v); }
typedef __bf16 bf16x2_t __attribute__((ext_vector_type(2)));
__device__ __forceinline__ unsigned pk_bf16(float lo, float hi) { f32x2 v; v.x = lo; v.y = hi; const bf16x2_t b = __builtin_convertvector(v, bf16x2_t); return __builtin_bit_cast(unsigned, b); }
__device__ __forceinline__ float sigmoidf_(float x) { return __builtin_amdgcn_rcpf(1.0f + __builtin_amdgcn_exp2f(x * -1.4426950408889634f)); }
__device__ __forceinline__ float wave_sum(float v) {
#pragma unroll
    for (int o = 32; o >= 1; o >>= 1) v += __shfl_xor(v, o);
    return v;
}

namespace pg8 {
constexpr int BM = 256, BK = 64, HALF = 128, HTB = HALF * BK * 2, STAGE_BYTES = 8 * HTB, NXCD = 8, WGM = 8;
__host__ __device__ __forceinline__ int lds_byte(int r, int c) { const int st = (r >> 4) * 2 + (c >> 5), rr = r & 15, cc = c & 31, ob = rr * 64 + cc * 2; return st * 1024 + (ob ^ (((ob >> 9) & 1) << 5)); }
__host__ __device__ __forceinline__ void stage_rc(int b, int& R, int& C) { const int st = b / 1024, sb = b % 1024, swz = sb ^ (((sb >> 9) & 1) << 5); R = (st >> 1) * 16 + swz / 64; C = (st & 1) * 32 + (swz % 64) / 2; }
__host__ __device__ __forceinline__ int perm32(int rho) { const int n = rho >> 4, i = rho & 15; return 8 * (i >> 2) + 4 * n + (i & 3); }
struct Unit { int pm, pn, roff, half; };
struct Gemm { const f16* A; const f16* Bt; int M, N, K, lda, ldb; };
struct StaticOrder {
    int nM, nN, nwg, G, c, nhalf;
    __device__ void init(int M, int N, int G_, int c_) { nM = M / BM; nN = N / BM; nwg = nM * nN; G = G_; c = c_; nhalf = 0; }
    __device__ void init_tail(int Mfull, int M, int N, int G_, int c_) { nM = Mfull / BM; nN = N / BM; nwg = nM * nN; G = G_; c = c_; nhalf = ((M - Mfull) / HALF) * nN; }
    __device__ bool next(int i, Unit& u) const {
        const long L = (long)i * G + c; if (L >= nwg + nhalf) return false;
        if (L >= nwg) { const int hx = (int)L - nwg, hp = hx / nN; u.pn = hx % nN; u.pm = nM + (hp >> 1); u.roff = (hp & 1) * HALF; u.half = 1; return true; }
        int wgid = (int)L; { const int q = nwg / NXCD, r = nwg % NXCD, xcd = wgid % NXCD, off = wgid / NXCD; wgid = (xcd < r ? xcd * (q + 1) : r * (q + 1) + (xcd - r) * q) + off; }
        const int nig = WGM * nN, gid = wgid / nig, fm = gid * WGM, gsz = (nM - fm) < WGM ? (nM - fm) : WGM;
        u.pm = fm + ((wgid % nig) % gsz); u.pn = (wgid % nig) / gsz; u.roff = 0; u.half = 0; return true;
    }
};

#ifndef PG8_SP2
#define PG8_SP2 true
#endif
#ifndef PG8_ALIGN
#define PG8_ALIGN true
#endif
template <bool BF16> __device__ __forceinline__ f32x4 mma16_(f16x8 b, f16x8 a, f32x4 c) {
    if constexpr (BF16) return __builtin_amdgcn_mfma_f32_16x16x32_bf16(__builtin_bit_cast(s16x8, b), __builtin_bit_cast(s16x8, a), c, 0, 0, 0);
    else return __builtin_amdgcn_mfma_f32_16x16x32_f16(b, a, c, 0, 0, 0);
}
template <class Epi, bool ALIGN_EPI = PG8_ALIGN, bool SP2 = PG8_SP2>
__device__ __forceinline__ void gemm_phase(LAS unsigned char* lds, const Gemm g, const StaticOrder& S, const Epi& E, unsigned* arrive_word = nullptr, int arrive_after = 0) {
    int tid_ = threadIdx.x; asm volatile("" : "+v"(tid_));
    const int tid = tid_, wid = __builtin_amdgcn_readfirstlane(tid >> 6), lane = tid & 63, wr = wid >> 2, wc = wid & 3, fr = lane & 15, fq = lane >> 4;
    const int K = g.K, nt = K / BK;
    unsigned voffA[2], voffB[2];
#pragma unroll
    for (int i = 0; i < 2; ++i) { int R, C; stage_rc(tid * 16 + i * 8192, R, C); const int Rb = Epi::PERM ? ((R & ~31) + perm32(R & 31)) : R;
        voffA[i] = (unsigned)(R * g.lda + C) * 2u; voffB[i] = (unsigned)(Rb * g.ldb + C) * 2u; }
    const size_t kstep = (size_t)(BK * 2);
    const size_t hA = (size_t)HALF * g.lda * 2, hB = (size_t)HALF * g.ldb * 2;
    const size_t tA = 2 * hA, tB = 2 * hB;
    const unsigned ldsw = (unsigned)wid * 1024u;
    const int aoff = lds_byte(wr * 64 + fr, fq * 8), boff = lds_byte(wc * 32 + fr, fq * 8);
#define PG8_SA(b, h) (((b) * 2 + (h)) * HTB)
#define PG8_SB(b, h) ((4 + (b) * 2 + (h)) * HTB)
#define PG8_STAGE(bufoff, gbase, voff) do { _Pragma("unroll") for (int _i = 0; _i < 2; ++_i) \
        __builtin_amdgcn_global_load_lds((const unsigned*)((const char*)(gbase) + (voff)[_i]), (LAS unsigned*)(lds + (bufoff) + ldsw + _i * 8192), 16, 0, 0); } while (0)
#define PG8_LDA(dst, b, h) do { _Pragma("unroll") for (int m = 0; m < 4; ++m) _Pragma("unroll") for (int k = 0; k < 2; ++k) dst[m][k] = *(const LAS f16x8*)(lds + PG8_SA(b, h) + aoff + m * 2048 + k * 1024); } while (0)
#define PG8_LDB(dst, b, h) do { _Pragma("unroll") for (int n = 0; n < 2; ++n) _Pragma("unroll") for (int k = 0; k < 2; ++k) dst[n][k] = *(const LAS f16x8*)(lds + PG8_SB(b, h) + boff + n * 2048 + k * 1024); } while (0)
#define PG8_MMA(ai, bj, At, Bt) do { __builtin_amdgcn_s_setprio(1); _Pragma("unroll") for (int m = 0; m < 4; ++m) _Pragma("unroll") for (int n = 0; n < 2; ++n) _Pragma("unroll") for (int k = 0; k < 2; ++k) \
        acc[ai][bj][m][n] = mma16_<Epi::BF16>(Bt[n][k], At[m][k], acc[ai][bj][m][n]); __builtin_amdgcn_s_setprio(0); } while (0)
#define PG8_WAIT_V(n) asm volatile("s_waitcnt vmcnt(" #n ")" ::: "memory")
#define PG8_WAIT_L(n) asm volatile("s_waitcnt lgkmcnt(" #n ")" ::: "memory")
#define PG8_BAR __builtin_amdgcn_s_barrier()
#define PG8_SCHED __builtin_amdgcn_sched_barrier(0)
    Unit cur, nxt; int ui = 0;
    if (!S.next(0, cur)) return;
    f32x4 acc[2][2][4][2];
#pragma unroll
    for (int a = 0; a < 2; ++a)
#pragma unroll
        for (int b = 0; b < 2; ++b)
#pragma unroll
            for (int m = 0; m < 4; ++m)
#pragma unroll
                for (int n = 0; n < 2; ++n) acc[a][b][m][n] = (f32x4){0.f, 0.f, 0.f, 0.f};
    f16x8 At[4][2], B0[2][2], B1[2][2];
    const char* cA = (const char*)g.A + (size_t)cur.pm * tA + (cur.roff ? hA : (size_t)0); const char* cB = (const char*)g.Bt + (size_t)cur.pn * tB;
    if constexpr (SP2) {
        PG8_STAGE(PG8_SB(0, 0), cB, voffB); PG8_STAGE(PG8_SB(0, 1), cB + hB, voffB); PG8_STAGE(PG8_SA(0, 0), cA, voffA); PG8_STAGE(PG8_SA(0, 1), cA + hA, voffA);
        if (wr == 1) PG8_BAR;
        PG8_WAIT_V(2); PG8_BAR;
        PG8_STAGE(PG8_SB(1, 0), cB + kstep, voffB); PG8_STAGE(PG8_SA(1, 0), cA + kstep, voffA); PG8_STAGE(PG8_SB(1, 1), cB + hB + kstep, voffB);
        PG8_WAIT_V(6); PG8_BAR;
    } else {
        PG8_STAGE(PG8_SB(0, 0), cB, voffB); PG8_STAGE(PG8_SA(0, 0), cA, voffA); PG8_STAGE(PG8_SB(0, 1), cB + hB, voffB); PG8_STAGE(PG8_SA(0, 1), cA + hA, voffA);
        if (wr == 1) PG8_BAR;
        PG8_WAIT_V(4); PG8_BAR;
        PG8_STAGE(PG8_SB(1, 0), cB + kstep, voffB); PG8_STAGE(PG8_SA(1, 0), cA + kstep, voffA); PG8_STAGE(PG8_SB(1, 1), cB + hB + kstep, voffB);
        PG8_WAIT_V(6); PG8_BAR;
    }
    for (;;) {
        const bool has_next = S.next(ui + 1, nxt);
        const char* nA = has_next ? (const char*)g.A + (size_t)nxt.pm * tA + (nxt.roff ? hA : (size_t)0) : cA; const char* nB = has_next ? (const char*)g.Bt + (size_t)nxt.pn * tB : cB;
        for (int t = 0; t < nt; t += 2) {
            const bool last = (t == nt - 2);
            const char* a1 = cA + (size_t)(t + 1) * kstep;
            const char* a2 = last ? nA : cA + (size_t)(t + 2) * kstep; const char* b2 = last ? nB : cB + (size_t)(t + 2) * kstep;
            const char* a3 = a2 + kstep; const char* b3 = b2 + kstep;
            if constexpr (SP2) {
            PG8_LDB(B0, 0, 0); PG8_LDB(B1, 0, 1); PG8_SCHED; PG8_LDA(At, 0, 0); PG8_STAGE(PG8_SA(1, 1), a1 + hA, voffA);
            PG8_WAIT_V(8); PG8_WAIT_L(0); PG8_BAR; PG8_MMA(0, 0, At, B0); PG8_MMA(0, 1, At, B1); PG8_BAR; PG8_SCHED;
            PG8_LDA(At, 0, 1); PG8_STAGE(PG8_SB(0, 0), b2, voffB); PG8_STAGE(PG8_SB(0, 1), b2 + hB, voffB); PG8_STAGE(PG8_SA(0, 0), a2, voffA);
            PG8_WAIT_V(8); PG8_WAIT_L(0); PG8_BAR; if (!cur.half) { PG8_MMA(1, 0, At, B0); PG8_MMA(1, 1, At, B1); } PG8_BAR; PG8_SCHED;
            PG8_LDB(B0, 1, 0); PG8_LDB(B1, 1, 1); PG8_SCHED; PG8_LDA(At, 1, 0); PG8_STAGE(PG8_SA(0, 1), a2 + hA, voffA);
            PG8_WAIT_V(8); PG8_WAIT_L(0); PG8_BAR; PG8_MMA(0, 0, At, B0); PG8_MMA(0, 1, At, B1); PG8_BAR; PG8_SCHED;
            PG8_LDA(At, 1, 1); PG8_STAGE(PG8_SB(1, 0), b3, voffB); PG8_STAGE(PG8_SB(1, 1), b3 + hB, voffB); PG8_STAGE(PG8_SA(1, 0), a3, voffA);
            PG8_WAIT_V(8); PG8_WAIT_L(0); PG8_BAR; if (!cur.half) { PG8_MMA(1, 0, At, B0); PG8_MMA(1, 1, At, B1); } PG8_BAR; PG8_SCHED;
            } else {
            PG8_LDB(B0, 0, 0); PG8_SCHED; PG8_LDA(At, 0, 0); PG8_STAGE(PG8_SA(1, 1), a1 + hA, voffA);
            PG8_WAIT_L(8); PG8_BAR; PG8_WAIT_L(0); PG8_MMA(0, 0, At, B0); PG8_BAR; PG8_SCHED;
            PG8_LDB(B1, 0, 1); PG8_STAGE(PG8_SB(0, 0), b2, voffB);
            PG8_BAR; PG8_WAIT_L(0); PG8_MMA(0, 1, At, B1); PG8_BAR;
            PG8_LDA(At, 0, 1); PG8_STAGE(PG8_SA(0, 0), a2, voffA);
            PG8_BAR; PG8_WAIT_L(0); if (!cur.half) PG8_MMA(1, 0, At, B0); PG8_BAR; PG8_SCHED;
            PG8_STAGE(PG8_SB(0, 1), b2 + hB, voffB);
            PG8_WAIT_V(6); PG8_BAR; if (!cur.half) PG8_MMA(1, 1, At, B1); PG8_BAR;
            PG8_LDB(B0, 1, 0); PG8_SCHED; PG8_LDA(At, 1, 0); PG8_STAGE(PG8_SA(0, 1), a2 + hA, voffA);
            PG8_WAIT_L(8); PG8_BAR; PG8_WAIT_L(0); PG8_MMA(0, 0, At, B0); PG8_BAR; PG8_SCHED;
            PG8_LDB(B1, 1, 1); PG8_STAGE(PG8_SB(1, 0), b3, voffB);
            PG8_BAR; PG8_WAIT_L(0); PG8_MMA(0, 1, At, B1); PG8_BAR;
            PG8_LDA(At, 1, 1); PG8_STAGE(PG8_SA(1, 0), a3, voffA);
            PG8_BAR; PG8_WAIT_L(0); if (!cur.half) PG8_MMA(1, 0, At, B0); PG8_BAR; PG8_SCHED;
            PG8_STAGE(PG8_SB(1, 1), b3 + hB, voffB);
            PG8_WAIT_V(6); PG8_BAR; if (!cur.half) PG8_MMA(1, 1, At, B1); PG8_BAR;
            }
        }
        if constexpr (ALIGN_EPI) { if (wr == 0) PG8_BAR; }
        E(acc, cur, wr, wc, fr, fq);
        if (ALIGN_EPI && arrive_word && ui + 1 == arrive_after) {
            asm volatile("s_waitcnt vmcnt(0) lgkmcnt(0)" ::: "memory"); PG8_BAR;
            if (tid == 0) { __builtin_amdgcn_fence(__ATOMIC_RELEASE, "agent"); asm volatile("s_waitcnt vmcnt(0)" ::: "memory");
                (void)__hip_atomic_fetch_add(arrive_word, 1u, __ATOMIC_RELAXED, __HIP_MEMORY_SCOPE_AGENT); } }
        if (!has_next) break;
#pragma unroll
        for (int a = 0; a < 2; ++a)
#pragma unroll
            for (int b = 0; b < 2; ++b)
#pragma unroll
                for (int m = 0; m < 4; ++m)
#pragma unroll
                    for (int n = 0; n < 2; ++n) acc[a][b][m][n] = (f32x4){0.f, 0.f, 0.f, 0.f};
        cur = nxt; cA = nA; cB = nB; ++ui;
        if constexpr (ALIGN_EPI) { if (wr == 1) PG8_BAR; }
    }
    PG8_WAIT_V(0);
    if constexpr (!ALIGN_EPI) { if (wr == 0) PG8_BAR; }
    PG8_BAR;
#undef PG8_SA
#undef PG8_SB
#undef PG8_STAGE
#undef PG8_LDA
#undef PG8_LDB
#undef PG8_MMA
#undef PG8_WAIT_V
#undef PG8_WAIT_L
#undef PG8_BAR
#undef PG8_SCHED
}
}
using pg8::Unit;
using pg8::Gemm;

struct EpiSwiglu {
    static constexpr bool PERM = true, BF16 = true;
    f16* O;
    __device__ __forceinline__ void operator()(const f32x4 (&acc)[2][2][4][2], const Unit& u, int wr, int wc, int fr, int fq) const {
        const int row0 = u.pm * 256 + wr * 64 + fr, col0 = u.pn * 128 + wc * 32 + 8 * fq;
#pragma unroll
        for (int ai = 0; ai < 2; ++ai)
#pragma unroll
            for (int m = 0; m < 4; ++m) {
                float o[8];
#pragma unroll
                for (int n = 0; n < 2; ++n)
#pragma unroll
                    for (int j = 0; j < 4; ++j) { const float up = acc[ai][0][m][n][j], gt = acc[ai][1][m][n][j]; o[n * 4 + j] = up * gt * sigmoidf_(gt); }
                u32x4 w; w.x = pk_bf16(o[0], o[1]); w.y = pk_bf16(o[2], o[3]); w.z = pk_bf16(o[4], o[5]); w.w = pk_bf16(o[6], o[7]);
                *(u32x4*)(O + (size_t)(row0 + ai * 128 + m * 16) * DFF + col0) = w;
            }
    }
};
struct EpiResid {
    static constexpr bool PERM = true, BF16 = true;
    const float* xl_src; const float* xc_src; f16* XH; float* out32; const float* gate; float coef; bool SRC32, DST32;
    __device__ __forceinline__ void operator()(const f32x4 (&acc)[2][2][4][2], const Unit& u, int wr, int wc, int fr, int fq) const {
        const bool lat = u.pm < 128; const int mi = lat ? (u.pm >> 4) : 8;
        const size_t inrow = (size_t)(u.roff + wr * 64 + fr) * DM + u.pn * 256 + wc * 32 + 8 * fq;
        const size_t gofs = (size_t)u.pm * 256 * DM + inrow;
        const float* s32 = (lat ? xl_src : xc_src) + (size_t)(lat ? u.pm : u.pm - 128) * 256 * DM + inrow;
        const float* gp = gate + (size_t)mi * NMOD + u.pn * 256 + wc * 32 + 8 * fq;
#pragma unroll
        for (int bj = 0; bj < 2; ++bj) { const f32x4 g0 = *(const f32x4*)(gp + bj * 128) * coef, g1 = *(const f32x4*)(gp + bj * 128 + 4) * coef;
#pragma unroll
            for (int ai = 0; ai < 2; ++ai) { if (ai == 1 && u.half) break;
#pragma unroll
                for (int m = 0; m < 4; ++m) { const size_t ro = (size_t)(ai * 128 + m * 16) * DM + bj * 128;
                    f32x4 x0, x1;
                    if (SRC32) { x0 = *(const f32x4*)(s32 + ro); x1 = *(const f32x4*)(s32 + ro + 4); }
                    else { const f16x8 t = *(const f16x8*)(XH + gofs + ro); x0 = (f32x4){(float)t[0], (float)t[1], (float)t[2], (float)t[3]}; x1 = (f32x4){(float)t[4], (float)t[5], (float)t[6], (float)t[7]}; }
                    x0 += g0 * acc[ai][bj][m][0]; x1 += g1 * acc[ai][bj][m][1];
                    if (DST32) { *(f32x4*)(out32 + gofs + ro) = x0; *(f32x4*)(out32 + gofs + ro + 4) = x1; }
                    else { u32x4 w; w.x = pk_f16(x0[0], x0[1]); w.y = pk_f16(x0[2], x0[3]); w.z = pk_f16(x1[0], x1[1]); w.w = pk_f16(x1[2], x1[3]); *(u32x4*)(XH + gofs + ro) = w; } } } }
    }
};
struct EpiWin {
    static constexpr bool PERM = true, BF16 = true;
    f16* Z; float* GLR;
    __device__ __forceinline__ void operator()(const f32x4 (&acc)[2][2][4][2], const Unit& u, int wr, int wc, int fr, int fq) const {
        const int row0 = u.pm * 256 + wr * 64 + fr;
        if (u.pn < 26) {
            const int col0 = u.pn * 256 + wc * 32 + 8 * fq;
#pragma unroll
            for (int ai = 0; ai < 2; ++ai)
#pragma unroll
                for (int m = 0; m < 4; ++m) { f16* rowp = Z + (size_t)(row0 + ai * 128 + m * 16) * ZLD + col0;
#pragma unroll
                    for (int bj = 0; bj < 2; ++bj) { const f32x4 v0 = acc[ai][bj][m][0], v1 = acc[ai][bj][m][1];
                        u32x4 w; w.x = pk_f16(v0[0], v0[1]); w.y = pk_f16(v0[2], v0[3]); w.z = pk_f16(v1[0], v1[1]); w.w = pk_f16(v1[2], v1[3]);
                        *(u32x4*)(rowp + bj * 128) = w; } }
        } else if (wc == 0) {
#pragma unroll
            for (int ai = 0; ai < 2; ++ai)
#pragma unroll
                for (int m = 0; m < 4; ++m) { float* rowp = GLR + (size_t)(row0 + ai * 128 + m * 16) * 32 + 8 * fq;
                    *(f32x4*)(rowp) = acc[ai][0][m][0]; *(f32x4*)(rowp + 4) = acc[ai][0][m][1]; }
        }
    }
};
template <bool SECOND> struct EpiMerge {
    static constexpr bool PERM = true, BF16 = false;
    f16* M16; const f16* G;
    __device__ __forceinline__ void operator()(const f32x4 (&acc)[2][2][4][2], const Unit& u, int wr, int wc, int fr, int fq) const {
        const int row0 = u.pm * 256 + u.roff + wr * 64 + fr, col0 = u.pn * 256 + wc * 32 + 8 * fq;
#pragma unroll
        for (int ai = 0; ai < 2; ++ai) { if (ai == 1 && u.half) break;
#pragma unroll
            for (int m = 0; m < 4; ++m) { const size_t r = (size_t)(row0 + ai * 128 + m * 16);
#pragma unroll
                for (int bj = 0; bj < 2; ++bj) {
                    const f16x8 gt = *(const f16x8*)(G + r * ZLD + col0 + bj * 128);
                    f16* mp = M16 + r * DM + col0 + bj * 128;
                    float o[8];
#pragma unroll
                    for (int n = 0; n < 2; ++n)
#pragma unroll
                        for (int j = 0; j < 4; ++j) o[n * 4 + j] = sigmoidf_((float)gt[n * 4 + j]) * acc[ai][bj][m][n][j];
                    if (SECOND) { const u32x4 pv = *(const u32x4*)mp; const unsigned pw[4] = {pv.x, pv.y, pv.z, pv.w};
#pragma unroll
                        for (int e = 0; e < 4; ++e) { o[2 * e] += __uint_as_float(pw[e] << 16); o[2 * e + 1] += __uint_as_float(pw[e] & 0xffff0000u); } }
                    u32x4 w; w.x = pk_bf16(o[0], o[1]); w.y = pk_bf16(o[2], o[3]); w.z = pk_bf16(o[4], o[5]); w.w = pk_bf16(o[6], o[7]);
                    *(u32x4*)mp = w; } } }
    }
};

struct Frame {
    LAS unsigned char* lds; int tid, lane, wave, G, bid;
    const float* in[23]; float* out; unsigned char* ws;
    float* MOD; float* ROPE; f16* W13T; f16* W2T; f16* WINT; f16* WBAT; f16* WBGT; f16* WOUTT; f16* XH; f16* H16; f16* OB; float* GLR; f16* Z;
};

__device__ __forceinline__ void conv_weight(const Frame& F, const float* src, f16* dst, int K, int ld, int Nd, int mode, int ci, int nc) {
    LAS f16* tile = (LAS f16*)F.lds;
    const int nkt = K / 128, nitems = (Nd / 64) * nkt;
    for (int it = ci; it < nitems; it += nc) {
        const int nt = it / nkt, kt = it % nkt, n0 = nt * 64;
        int sc = n0, valid = 64;
        if (mode == 1) { const int pn = n0 >> 8, w = n0 & 255; sc = (w < 128) ? (pn * 128 + w) : (DFF + pn * 128 + w - 128); }
        else if (mode == 2) { if (n0 < 2048) sc = n0; else if (n0 < 6656) sc = n0 + 32; else if (n0 == 6656) { sc = 2048; valid = 32; } else { sc = 0; valid = 0; } }
        __syncthreads();
#pragma unroll
        for (int q = 0; q < 4; ++q) {
            const int idx = F.tid + q * NTHR, kr = idx >> 4, c4 = (idx & 15) * 4;
            f32x4 v = (f32x4){0.f, 0.f, 0.f, 0.f};
            if (c4 < valid) v = *(const f32x4*)(src + (size_t)(kt * 128 + kr) * ld + sc + c4);
#pragma unroll
            for (int e = 0; e < 4; ++e) { if (mode != 0) ((LAS unsigned short*)tile)[(c4 + e) * 136 + kr] = (unsigned short)(pk_bf16(v[e], v[e]) & 0xffffu); else tile[(c4 + e) * 136 + kr] = (f16)v[e]; }
        }
        __syncthreads();
#pragma unroll
        for (int q = 0; q < 2; ++q) {
            const int ch = F.tid + q * NTHR, n = ch >> 4, kc = (ch & 15) * 8;
            *(u32x4*)(dst + (size_t)(n0 + n) * K + kt * 128 + kc) = *(const LAS u32x4*)(tile + n * 136 + kc);
        }
    }
    __syncthreads();
}

__device__ __forceinline__ void phase_mod(const Frame& F) {
    LAS float* cond = (LAS float*)F.lds;
    LAS float* red = (LAS float*)(F.lds + 9 * 1024 * 4);
    for (int i = F.tid; i < 9 * 1024; i += NTHR) { const float v = (i < 8192) ? F.in[1][i] : F.in[3][i - 8192]; cond[i] = v * sigmoidf_(v); }
    __syncthreads();
    const int col = F.tid & 63, kq = F.tid >> 6;
    for (int it = F.bid; it < DEPTH * 144; it += F.G) {
        const int l = it / 144, n = (it % 144) * 64 + col;
        const float* wp = F.in[4] + (size_t)l * DM * NMOD + n;
        float a[9];
#pragma unroll
        for (int i = 0; i < 9; ++i) a[i] = 0.f;
#pragma unroll 16
        for (int k = kq * 128; k < kq * 128 + 128; ++k) { const float w = wp[(size_t)k * NMOD];
#pragma unroll
            for (int i = 0; i < 9; ++i) a[i] += cond[i * 1024 + k] * w; }
        __syncthreads();
#pragma unroll
        for (int i = 0; i < 9; ++i) red[(kq * 9 + i) * 64 + col] = a[i];
        __syncthreads();
        if (kq == 0) { float bb = F.in[5][(size_t)l * NMOD + n];
#pragma unroll
            for (int i = 0; i < 9; ++i) { float t = bb;
#pragma unroll
                for (int q = 0; q < 8; ++q) t += red[(q * 9 + i) * 64 + col];
                F.MOD[((size_t)l * 9 + i) * NMOD + n] = t; } }
    }
    const int gt = F.bid * NTHR + F.tid;
    if (gt < 2048) { const int pos = gt >> 5, i = gt & 31; const float inv = exp2f(-(float)i * (13.287712379549449f / 32.0f)); const float ang = (float)pos * inv;
        float rev = ang * 0.15915494309189535f; rev -= rintf(rev);
        const float r = rev * 6.283185307179586f;
        F.ROPE[gt * 2] = __cosf(r); F.ROPE[gt * 2 + 1] = __sinf(r); }
    __syncthreads();
}

__device__ __forceinline__ void phase_norm(const Frame& F, const float* xl, const float* xc, const f16* x16, int l, int which, int r0, int nrows, int ci, int nc) {
    const float* nw = F.in[6] + ((size_t)l * 3 + which) * DM;
    const int gw = r0 + ci * 8 + F.wave, nw_ = nc * 8;
    for (int row = gw; row < nrows; row += nw_) {
        const bool lat = row < TL; const int mi = lat ? (row >> 12) : 8;
        const float* sh = F.MOD + ((size_t)l * 9 + mi) * NMOD + (3 * which) * DM; const float* sc = sh + DM;
        float v[2][8]; float ss = 0.f;
        if (x16) {
            const f16* xp = x16 + (size_t)row * DM;
#pragma unroll
            for (int j = 0; j < 2; ++j) { const f16x8 t = *(const f16x8*)(xp + j * 512 + F.lane * 8);
#pragma unroll
                for (int e = 0; e < 8; ++e) v[j][e] = (float)t[e]; }
        } else {
            const float* xp = lat ? xl + (size_t)row * DM : xc + (size_t)(row - TL) * DM;
#pragma unroll
            for (int j = 0; j < 2; ++j) { const f32x4 a = *(const f32x4*)(xp + j * 512 + F.lane * 8), b = *(const f32x4*)(xp + j * 512 + F.lane * 8 + 4);
#pragma unroll
                for (int e = 0; e < 4; ++e) { v[j][e] = a[e]; v[j][4 + e] = b[e]; } }
        }
#pragma unroll
        for (int j = 0; j < 2; ++j)
#pragma unroll
            for (int e = 0; e < 8; ++e) ss += v[j][e] * v[j][e];
        ss = wave_sum(ss);
        const float rstd = rsqrtf(ss * (1.0f / DM) + 1e-6f);
#pragma unroll
        for (int j = 0; j < 2; ++j) { const int k = j * 512 + F.lane * 8;
            float o[8];
#pragma unroll
            for (int q = 0; q < 2; ++q) { const f32x4 w = *(const f32x4*)(nw + k + 4 * q), s1 = *(const f32x4*)(sc + k + 4 * q), s0 = *(const f32x4*)(sh + k + 4 * q);
#pragma unroll
                for (int e = 0; e < 4; ++e) o[4 * q + e] = v[j][4 * q + e] * rstd * w[e] * (1.0f + s1[e]) + s0[e]; }
            u32x4 pk;
            if (true) { pk.x = pk_bf16(o[0], o[1]); pk.y = pk_bf16(o[2], o[3]); pk.z = pk_bf16(o[4], o[5]); pk.w = pk_bf16(o[6], o[7]); }
            else { pk.x = pk_f16(o[0], o[1]); pk.y = pk_f16(o[2], o[3]); pk.z = pk_f16(o[4], o[5]); pk.w = pk_f16(o[6], o[7]); }
            *(u32x4*)(F.H16 + (size_t)row * DM + k) = pk; }
    }
}

__device__ __forceinline__ void phase_qkprep(const Frame& F, int l, bool last, int ci, int nc) {
    const float* qnw = F.in[12] + l * 128; const float* knw = F.in[13] + l * 128;
    const int lane = F.lane, j = lane & 7, hd = lane >> 3;
    const float QS = 0.08838834764831845f * 1.4426950408889634f;
    float wq[16], wk[16];
#pragma unroll
    for (int e = 0; e < 16; ++e) { wq[e] = qnw[j * 16 + e] * QS; wk[e] = knw[j * 16 + e]; }
    const bool second = (j & 2) != 0;
    const int gw = ci * 8 + F.wave, nw_ = nc * 8;
    for (int row = gw; row < TT; row += nw_) {
        const bool lat = row < TL;
        float cs[16], sn[16];
        if (lat) { const int t = row & 4095, pos = (j < 4) ? (t >> 6) : (t & 63); const float* tp = F.ROPE + (pos * 32 + (j & 1) * 16) * 2;
#pragma unroll
            for (int q4 = 0; q4 < 8; ++q4) { const f32x4 v = *(const f32x4*)(tp + q4 * 4); cs[q4 * 2] = v[0]; sn[q4 * 2] = v[1]; cs[q4 * 2 + 1] = v[2]; sn[q4 * 2 + 1] = v[3]; } }
        else {
#pragma unroll
            for (int e = 0; e < 16; ++e) { cs[e] = 1.f; sn[e] = 0.f; } }
        f16* zp = F.Z + (size_t)row * ZLD;
#pragma unroll
        for (int pass = 0; pass < 2; ++pass) {
            if (pass == 0 && !lat && last) continue;
            if (pass == 1 && hd >= 2) continue;
            f16* p = (pass == 0 ? zp + Z_AQ : zp + Z_AK) + hd * 128 + j * 16;
            const f16x8 r0 = *(const f16x8*)p, r1 = *(const f16x8*)(p + 8);
            float x[16]; float ss = 0.f;
#pragma unroll
            for (int e = 0; e < 8; ++e) { x[e] = (float)r0[e]; x[8 + e] = (float)r1[e]; }
#pragma unroll
            for (int e = 0; e < 16; ++e) ss += x[e] * x[e];
            ss += __shfl_xor(ss, 1); ss += __shfl_xor(ss, 2); ss += __shfl_xor(ss, 4);
            const float rstd = rsqrtf(ss * (1.0f / 128.0f) + 1e-6f);
            float o[16];
#pragma unroll
            for (int e = 0; e < 16; ++e) { const float xn = x[e] * rstd * (pass == 0 ? wq[e] : wk[e]); const float pn = __shfl_xor(xn, 2);
                o[e] = second ? (pn * sn[e] + xn * cs[e]) : (xn * cs[e] - pn * sn[e]); }
            u32x4 w0, w1; w0.x = pk_f16(o[0], o[1]); w0.y = pk_f16(o[2], o[3]); w0.z = pk_f16(o[4], o[5]); w0.w = pk_f16(o[6], o[7]);
            w1.x = pk_f16(o[8], o[9]); w1.y = pk_f16(o[10], o[11]); w1.z = pk_f16(o[12], o[13]); w1.w = pk_f16(o[14], o[15]);
            *(u32x4*)p = w0; *(u32x4*)(p + 8) = w1;
        }
    }
}

constexpr int GL_RQ = 0;
constexpr int GL_AM = GL_RQ;
constexpr int GL_RK = GL_RQ + 64 * 136 * 2;
constexpr int GL_LR = GL_RK + 64 * 136 * 2;
constexpr int GL_QT = GL_LR + 64 * 16 * 4;
constexpr int GL_KH = GL_QT + 64 * 136 * 2;
constexpr int GL_KT = GL_KH + 64 * 136 * 2;
constexpr int GL_VT = GL_KT + 128 * 72 * 2;
constexpr int GL_ST = GL_VT + 128 * 72 * 2;
constexpr int GL_EB = GL_ST + 128 * 136 * 2;
constexpr int GL_PS = GL_EB + 512;
constexpr int GL_END = GL_PS + 2048;
static_assert(GL_END + 16 <= LDS_BYTES, "GLA LDS");

__device__ __forceinline__ void phase_gla(const Frame& F, int l, int gi, int ng) {
    LAS unsigned char* lds = F.lds;
    const int tid = F.tid, lane = F.lane, w = F.wave, r32 = lane & 31, hh = lane >> 5;
    for (int item = gi; item < 128; item += ng) {
        const int b = item & 7, idx = item >> 3, h = idx >> 2, dir = (idx >> 1) & 1, sl = idx & 1;
        const float* gwp = (dir ? F.in[17] : F.in[15]) + (size_t)l * 16 * 512 + h * 128;
        const float* gbp = (dir ? F.in[18] : F.in[16]) + (size_t)l * 512 + h * 128;
        f16* Oout = dir ? F.OB : F.H16;
        const int d = tid & 127, tg = tid >> 7;
        f16x8 gwf;
#pragma unroll
        for (int j = 0; j < 8; ++j) gwf[j] = (f16)gwp[(hh * 8 + j) * 512 + (w & 3) * 32 + r32];
        const float gbv = gbp[(w & 3) * 32 + r32];
        const int li = tid >> 3, ls = tid & 7;
        const int vi = tid & 63, vs = tid >> 6;
        const int it = w >> 2, et = w & 3;
        const int dt = w >> 1, e2 = (w & 1) * 2;
        f32x16 Sacc[2];
#pragma unroll
        for (int q = 0; q < 2; ++q)
#pragma unroll
            for (int e = 0; e < 16; ++e) Sacc[q][e] = 0.f;
        __syncthreads();
        for (int i = tid; i < 128 * 136 / 2; i += NTHR) ((LAS unsigned*)(lds + GL_ST))[i] = 0u;
        u32x4 pq0, pq1, pk0, pk1, pv0, pv1; f32x2 pg;
        auto chunk_base = [&](int s) -> int { return (s < 4) ? (TL + b * CTXL + (dir ? 3 - s : s) * 64) : (b * SEQ + (dir ? 63 - (s - 4) : (s - 4)) * 64); };
#define GLA_LOAD(s) do { const int _row = chunk_base(s) + (dir ? 63 - li : li); const f16* _zp = F.Z + (size_t)_row * ZLD; \
            pq0 = *(const u32x4*)(_zp + Z_GQ + h * 128 + ls * 16); pq1 = *(const u32x4*)(_zp + Z_GQ + h * 128 + ls * 16 + 8); \
            pk0 = *(const u32x4*)(_zp + Z_GK + h * 128 + ls * 16); pk1 = *(const u32x4*)(_zp + Z_GK + h * 128 + ls * 16 + 8); \
            { const f16* _vp = F.Z + (size_t)(chunk_base(s) + (dir ? 63 - vi : vi)) * ZLD + Z_GV + h * 256 + sl * 128 + vs * 16; pv0 = *(const u32x4*)_vp; pv1 = *(const u32x4*)(_vp + 8); } \
            pg = *(const f32x2*)(F.GLR + (size_t)_row * 32 + dir * 16 + ls * 2); } while (0)
        GLA_LOAD(0);
        for (int s = 0; s < 68; ++s) {
            *(LAS u32x4*)(lds + GL_RQ + (li * 136 + ls * 16) * 2) = pq0; *(LAS u32x4*)(lds + GL_RQ + (li * 136 + ls * 16 + 8) * 2) = pq1;
            *(LAS u32x4*)(lds + GL_RK + (li * 136 + ls * 16) * 2) = pk0; *(LAS u32x4*)(lds + GL_RK + (li * 136 + ls * 16 + 8) * 2) = pk1;
            *(LAS unsigned*)(lds + GL_LR + (li * 16 + ls * 2) * 2) = pk_f16(pg.x, pg.y);
            { const f16x8 va = __builtin_bit_cast(f16x8, pv0), vb = __builtin_bit_cast(f16x8, pv1);
#pragma unroll
              for (int e = 0; e < 8; e += 2) { const unsigned pa = pk_bf16((float)va[e], (float)va[e + 1]), pb = pk_bf16((float)vb[e], (float)vb[e + 1]);
                  *(LAS unsigned short*)(lds + GL_VT + ((vs * 16 + e) * 72 + vi) * 2) = (unsigned short)(pa & 0xffffu);
                  *(LAS unsigned short*)(lds + GL_VT + ((vs * 16 + e + 1) * 72 + vi) * 2) = (unsigned short)(pa >> 16);
                  *(LAS unsigned short*)(lds + GL_VT + ((vs * 16 + 8 + e) * 72 + vi) * 2) = (unsigned short)(pb & 0xffffu);
                  *(LAS unsigned short*)(lds + GL_VT + ((vs * 16 + 8 + e + 1) * 72 + vi) * 2) = (unsigned short)(pb >> 16); } }
            __syncthreads();
            if (s + 1 < 68) GLA_LOAD(s + 1);
            { const f16x8 ga = *(const LAS f16x8*)(lds + GL_LR + ((w >> 2) * 32 + r32) * 32 + hh * 16);
              f32x16 la;
#pragma unroll
              for (int e = 0; e < 16; ++e) la[e] = 0.f;
              la = __builtin_amdgcn_mfma_f32_32x32x16_f16(ga, gwf, la, 0, 0, 0);
#pragma unroll
              for (int e = 0; e < 16; ++e) { const int i = (w >> 2) * 32 + (e & 3) + 8 * (e >> 2) + 4 * hh; const float lg = la[e] + gbv;
                  ((LAS float*)(lds + GL_QT))[i * 128 + (w & 3) * 32 + r32] = (fminf(lg, 0.f) * 1.4426950408889634f - __builtin_amdgcn_logf(1.0f + __builtin_amdgcn_exp2f(fabsf(lg) * -1.4426950408889634f))) * (1.0f / 16.0f); } }
            __syncthreads();
            float bl[16]; float cum = 0.f;
#pragma unroll
            for (int ii = 0; ii < 16; ++ii) { cum += ((const LAS float*)(lds + GL_QT))[(tg * 16 + ii) * 128 + d]; bl[ii] = cum; }
            ((LAS float*)(lds + GL_PS))[tg * 128 + d] = cum;
            __syncthreads();
            float off = 0.f, tot = 0.f;
#pragma unroll
            for (int t2 = 0; t2 < 4; ++t2) { const float pv2 = ((LAS float*)(lds + GL_PS))[t2 * 128 + d]; tot += pv2; if (t2 < tg) off += pv2; }
            const float etot = __builtin_amdgcn_exp2f(tot);
            if (tg == 0) ((LAS float*)(lds + GL_EB))[d] = etot;
            { unsigned ktp[8];
#pragma unroll
              for (int ii = 0; ii < 16; ii += 2) {
                  float kt2[2];
#pragma unroll
                  for (int e = 0; e < 2; ++e) { const int i = tg * 16 + ii + e; const float bi = off + bl[ii + e];
                      const float qv = (float)*(const LAS f16*)(lds + GL_RQ + (i * 136 + d) * 2), kv = (float)*(const LAS f16*)(lds + GL_RK + (i * 136 + d) * 2);
                      const float qt = qv * 0.08838834764831845f * __builtin_amdgcn_exp2f(bi), kh = kv * __builtin_amdgcn_exp2f(-bi); kt2[e] = kh * etot;
                      *(LAS unsigned short*)(lds + GL_QT + (i * 136 + d) * 2) = (unsigned short)(pk_bf16(qt, qt) & 0xffffu);
                      *(LAS unsigned short*)(lds + GL_KH + (i * 136 + d) * 2) = (unsigned short)(pk_bf16(kh, kh) & 0xffffu); }
                  ktp[ii >> 1] = pk_bf16(kt2[0], kt2[1]); }
              *(LAS u32x4*)(lds + GL_KT + (d * 72 + tg * 16) * 2) = (u32x4){ktp[0], ktp[1], ktp[2], ktp[3]};
              *(LAS u32x4*)(lds + GL_KT + (d * 72 + tg * 16 + 8) * 2) = (u32x4){ktp[4], ktp[5], ktp[6], ktp[7]}; }
            __syncthreads();
            f32x16 oacc;
#pragma unroll
            for (int e = 0; e < 16; ++e) oacc[e] = 0.f;
#pragma unroll
            for (int ks = 0; ks < 8; ++ks) {
                const s16x8 a = *(const LAS s16x8*)(lds + GL_QT + ((it * 32 + r32) * 136 + ks * 16 + hh * 8) * 2);
                const s16x8 bb = *(const LAS s16x8*)(lds + GL_ST + ((et * 32 + r32) * 136 + ks * 16 + hh * 8) * 2);
                oacc = __builtin_amdgcn_mfma_f32_32x32x16_bf16(a, bb, oacc, 0, 0, 0); }
            if (w >= 4 && w < 7) {
                const int jt = (w == 6) ? 1 : 0, it2 = (w == 4) ? 0 : 1;
                f32x16 aacc;
#pragma unroll
                for (int e = 0; e < 16; ++e) aacc[e] = 0.f;
#pragma unroll
                for (int ks = 0; ks < 8; ++ks) {
                    const s16x8 a = *(const LAS s16x8*)(lds + GL_KH + ((jt * 32 + r32) * 136 + ks * 16 + hh * 8) * 2);
                    const s16x8 bb = *(const LAS s16x8*)(lds + GL_QT + ((it2 * 32 + r32) * 136 + ks * 16 + hh * 8) * 2);
                    aacc = __builtin_amdgcn_mfma_f32_32x32x16_bf16(a, bb, aacc, 0, 0, 0); }
                const int i = it2 * 32 + r32;
#pragma unroll
                for (int g4 = 0; g4 < 4; ++g4) { const int j0 = jt * 32 + g4 * 8 + hh * 4; float v4[4];
#pragma unroll
                    for (int e = 0; e < 4; ++e) v4[e] = (j0 + e <= i) ? aacc[g4 * 4 + e] : 0.f;
                    *(LAS u32x2*)(lds + GL_AM + (i * 72 + j0) * 2) = (u32x2){pk_bf16(v4[0], v4[1]), pk_bf16(v4[2], v4[3])}; }
            } else if (w == 7) {
#pragma unroll
                for (int q = 0; q < 4; ++q) { const int ci = lane + q * 64, i = ci >> 3, j0 = 32 + (ci & 7) * 4; *(LAS u32x2*)(lds + GL_AM + (i * 72 + j0) * 2) = (u32x2){0u, 0u}; }
            }
            __syncthreads();
#pragma unroll
            for (int ks = 0; ks < 4; ++ks) {
                const s16x8 a = *(const LAS s16x8*)(lds + GL_AM + ((it * 32 + r32) * 72 + ks * 16 + hh * 8) * 2);
                const s16x8 bb = *(const LAS s16x8*)(lds + GL_VT + ((et * 32 + r32) * 72 + ks * 16 + hh * 8) * 2);
                oacc = __builtin_amdgcn_mfma_f32_32x32x16_bf16(a, bb, oacc, 0, 0, 0); }
            { const int cb = chunk_base(s), i0 = it * 32 + 4 * hh; const long rs = dir ? -(long)DM : (long)DM;
              f16* ob = Oout + (size_t)(cb + (dir ? 63 - i0 : i0)) * DM + h * 256 + sl * 128 + et * 32 + r32;
#pragma unroll
              for (int e = 0; e < 16; ++e) ob[((e & 3) + 8 * (e >> 2)) * rs] = (f16)oacc[e]; }
#pragma unroll
            for (int q = 0; q < 2; ++q) {
#pragma unroll
                for (int g4 = 0; g4 < 4; ++g4) { const f32x4 ev = *(const LAS f32x4*)(lds + GL_EB + (dt * 32 + g4 * 8 + hh * 4) * 4);
#pragma unroll
                    for (int e = 0; e < 4; ++e) Sacc[q][g4 * 4 + e] *= ev[e]; }
#pragma unroll
                for (int ks = 0; ks < 4; ++ks) {
                    const s16x8 a = *(const LAS s16x8*)(lds + GL_KT + ((dt * 32 + r32) * 72 + ks * 16 + hh * 8) * 2);
                    const s16x8 bb = *(const LAS s16x8*)(lds + GL_VT + (((e2 + q) * 32 + r32) * 72 + ks * 16 + hh * 8) * 2);
                    Sacc[q] = __builtin_amdgcn_mfma_f32_32x32x16_bf16(a, bb, Sacc[q], 0, 0, 0); }
#pragma unroll
                for (int g4 = 0; g4 < 4; ++g4)
                    *(LAS u32x2*)(lds + GL_ST + (((e2 + q) * 32 + r32) * 136 + dt * 32 + g4 * 8 + hh * 4) * 2) = (u32x2){pk_bf16(Sacc[q][g4 * 4], Sacc[q][g4 * 4 + 1]), pk_bf16(Sacc[q][g4 * 4 + 2], Sacc[q][g4 * 4 + 3])};
            }
            __syncthreads();
        }
#undef GLA_LOAD
    }
}

__device__ __forceinline__ void phase_glacomb(const Frame& F, int l, int nrows) {
    const float* gnw = F.in[19] + l * 256;
    float wv[16];
#pragma unroll
    for (int e = 0; e < 16; ++e) wv[e] = gnw[(F.lane & 15) * 16 + e];
    const int gw = F.bid * 8 + F.wave, nw_ = F.G * 8;
    for (int row = gw; row < nrows; row += nw_) {
        const size_t o = (size_t)row * DM + F.lane * 16;
        const f16x8 a0 = *(const f16x8*)(F.H16 + o), a1 = *(const f16x8*)(F.H16 + o + 8), b0 = *(const f16x8*)(F.OB + o), b1 = *(const f16x8*)(F.OB + o + 8);
        f16* gp = F.Z + (size_t)row * ZLD + Z_GR + F.lane * 16;
        const f16x8 r0 = *(const f16x8*)gp, r1 = *(const f16x8*)(gp + 8);
        float v[16], r[16]; float ss = 0.f;
#pragma unroll
        for (int e = 0; e < 8; ++e) { v[e] = (float)a0[e] + (float)b0[e]; v[8 + e] = (float)a1[e] + (float)b1[e]; r[e] = (float)r0[e]; r[8 + e] = (float)r1[e]; }
#pragma unroll
        for (int e = 0; e < 16; ++e) ss += v[e] * v[e];
        ss += __shfl_xor(ss, 1); ss += __shfl_xor(ss, 2); ss += __shfl_xor(ss, 4); ss += __shfl_xor(ss, 8);
        const float rstd = rsqrtf(ss * (1.0f / 256.0f) + 1e-6f);
        float y[16];
#pragma unroll
        for (int e = 0; e < 16; ++e) y[e] = v[e] * rstd * wv[e] * r[e] * sigmoidf_(r[e]);
        u32x4 w0, w1; w0.x = pk_f16(y[0], y[1]); w0.y = pk_f16(y[2], y[3]); w0.z = pk_f16(y[4], y[5]); w0.w = pk_f16(y[6], y[7]);
        w1.x = pk_f16(y[8], y[9]); w1.y = pk_f16(y[10], y[11]); w1.z = pk_f16(y[12], y[13]); w1.w = pk_f16(y[14], y[15]);
        *(u32x4*)gp = w0; *(u32x4*)(gp + 8) = w1;
    }
}

constexpr int AT_K = 0;
constexpr int AT_V = AT_K + 64 * 136 * 2;
constexpr int AT_BUF = AT_V + 128 * 72 * 2;
constexpr int AT_P = 2 * AT_BUF;
constexpr int AT_END = AT_P + 8 * 32 * 72 * 2;
static_assert(AT_END <= LDS_BYTES, "attn LDS");

__device__ __forceinline__ void phase_attn(const Frame& F, int l, bool last, int ai, int na) {
    LAS unsigned char* lds = F.lds;
    const int tid = F.tid, lane = F.lane, w = F.wave, r32 = lane & 31, hh = lane >> 5;
    const int nitems = last ? 1024 : 1088;
    const float* sinkp = F.in[14] + l * 8;
    const int kkey = tid >> 3, kseg = (tid & 7) * 16;
    const int vkp = tid & 31, vdg = tid >> 5;
    LAS unsigned char* Pw = lds + AT_P + w * (32 * 72 * 2);
    for (int item = ai; item < nitems; item += na) {
        int b, qb, hk, hp; bool isctx;
        if (item < 1024) { isctx = false; b = item & 7; const int r = item >> 3; hk = r & 1; hp = (r >> 1) & 1; qb = r >> 2; }
        else { isctx = true; const int r = item - 1024; b = r & 7; hk = (r >> 3) & 1; hp = (r >> 4) & 1; qb = r >> 5; }
        const int hq = hk * 4 + hp * 2 + (w >> 2);
        const int qrow0 = (isctx ? TL + b * CTXL : b * SEQ) + qb * 128 + (w & 3) * 32;
        f16x8 qf[8];
        { const f16* qp = F.Z + (size_t)(qrow0 + r32) * ZLD + Z_AQ + hq * 128 + hh * 8;
#pragma unroll
          for (int s = 0; s < 8; ++s) qf[s] = *(const f16x8*)(qp + s * 16); }
        const float sk = sinkp[hq] * 1.4426950408889634f;
        float mrun = sk, lrun = 1.0f;
        f32x16 oacc[4];
#pragma unroll
        for (int dt = 0; dt < 4; ++dt)
#pragma unroll
            for (int e = 0; e < 16; ++e) oacc[dt][e] = 0.f;
        int wlo = 0, nwin = 0;
        if (!isctx) { const int lo = (qb == 0) ? 0 : qb * 128 - 128, hi = (qb == 31) ? SEQ : qb * 128 + 256; wlo = lo; nwin = (hi - lo) >> 6; }
        const int ntile = nwin + 4;
        const int qpos = qb * 128 + (w & 3) * 32 + r32;
        u32x4 k0, k1, v0, v1;
#define AT_LOAD(t) do { int _kr0; if ((t) < nwin) _kr0 = b * SEQ + wlo + (t) * 64; else _kr0 = TL + b * CTXL + ((t) - nwin) * 64; \
            const f16* _kp = F.Z + (size_t)(_kr0 + kkey) * ZLD + Z_AK + hk * 128 + kseg; k0 = *(const u32x4*)_kp; k1 = *(const u32x4*)(_kp + 8); \
            const f16* _vp = F.Z + (size_t)(_kr0 + 2 * vkp) * ZLD + Z_AV + hk * 128 + vdg * 8; v0 = *(const u32x4*)_vp; v1 = *(const u32x4*)(_vp + ZLD); } while (0)
        AT_LOAD(0);
#define AT_STORE(bo) do { *(LAS u32x4*)(lds + (bo) + AT_K + (kkey * 136 + kseg) * 2) = k0; *(LAS u32x4*)(lds + (bo) + AT_K + (kkey * 136 + kseg + 8) * 2) = k1; \
            const unsigned a0[4] = {v0.x, v0.y, v0.z, v0.w}, a1[4] = {v1.x, v1.y, v1.z, v1.w}; \
            _Pragma("unroll") for (int e = 0; e < 4; ++e) { \
                const unsigned lo = (a0[e] & 0xffffu) | (a1[e] << 16), hi = (a0[e] >> 16) | (a1[e] & 0xffff0000u); \
                *(LAS unsigned*)(lds + (bo) + AT_V + ((vdg * 8 + 2 * e) * 72 + 2 * vkp) * 2) = lo; \
                *(LAS unsigned*)(lds + (bo) + AT_V + ((vdg * 8 + 2 * e + 1) * 72 + 2 * vkp) * 2) = hi; } } while (0)
        __syncthreads();
        AT_STORE(0);
        if (ntile > 1) AT_LOAD(1);
        for (int t = 0; t < ntile; ++t) {
            const int bo = (t & 1) * AT_BUF;
            __syncthreads();
            if (t + 1 < ntile) { AT_STORE(AT_BUF - bo); if (t + 2 < ntile) AT_LOAD(t + 2); }
            const int kpos0 = wlo + t * 64, q0w = qb * 128 + (w & 3) * 32;
            const bool win = (t < nwin) && !(kpos0 <= q0w + 65 && kpos0 >= q0w - 97);
            if ((t < nwin) && (kpos0 > q0w + 159 || kpos0 < q0w - 191)) continue;
            f32x16 sacc[2];
#pragma unroll
            for (int kt = 0; kt < 2; ++kt) {
#pragma unroll
                for (int e = 0; e < 16; ++e) sacc[kt][e] = 0.f;
#pragma unroll
                for (int s = 0; s < 8; ++s) { const f16x8 a = *(const LAS f16x8*)(lds + bo + AT_K + ((kt * 32 + r32) * 136 + s * 16 + hh * 8) * 2);
                    sacc[kt] = __builtin_amdgcn_mfma_f32_32x32x16_f16(a, qf[s], sacc[kt], 0, 0, 0); } }
            float mx = -1e30f;
#pragma unroll
            for (int kt = 0; kt < 2; ++kt)
#pragma unroll
                for (int e = 0; e < 16; ++e) {
                    if (win) { const int kp = kpos0 + kt * 32 + (e & 3) + 8 * (e >> 2) + 4 * hh; const int dd = kp - qpos; if (dd > 128 || dd < -128) sacc[kt][e] = -1e30f; }
                    mx = fmaxf(mx, sacc[kt][e]); }
            mx = fmaxf(mx, __shfl_xor(mx, 32));
            const bool upd = mx > mrun + 8.0f;
            const bool anyupd = __builtin_amdgcn_ballot_w64(upd) != 0ull;
            const float mnew = upd ? mx : mrun;
            float rs = 0.f;
#pragma unroll
            for (int kt = 0; kt < 2; ++kt)
#pragma unroll
                for (int g4 = 0; g4 < 4; ++g4) { float pv4[4];
#pragma unroll
                    for (int e = 0; e < 4; ++e) { pv4[e] = __builtin_amdgcn_exp2f(sacc[kt][g4 * 4 + e] - mnew); rs += pv4[e]; }
                    *(LAS u32x2*)(Pw + (r32 * 72 + kt * 32 + g4 * 8 + hh * 4) * 2) = (u32x2){pk_f16(pv4[0], pv4[1]), pk_f16(pv4[2], pv4[3])}; }
            rs += __shfl_xor(rs, 32);
            if (anyupd) { const float alpha = __builtin_amdgcn_exp2f(mrun - mnew); lrun *= alpha;
#pragma unroll
                for (int dt = 0; dt < 4; ++dt)
#pragma unroll
                    for (int e = 0; e < 16; ++e) oacc[dt][e] *= alpha; }
            lrun += rs; mrun = mnew;
            asm volatile("s_waitcnt lgkmcnt(0)" ::: "memory");
#pragma unroll
            for (int s = 0; s < 4; ++s) { const f16x8 pb = *(const LAS f16x8*)(Pw + (r32 * 72 + s * 16 + hh * 8) * 2);
#pragma unroll
                for (int dt = 0; dt < 4; ++dt) { const f16x8 a = *(const LAS f16x8*)(lds + bo + AT_V + ((dt * 32 + r32) * 72 + s * 16 + hh * 8) * 2);
                    oacc[dt] = __builtin_amdgcn_mfma_f32_32x32x16_f16(a, pb, oacc[dt], 0, 0, 0); } }
        }
#undef AT_LOAD
#undef AT_STORE
        const float inv = 1.0f / lrun;
        f16* op = F.Z + (size_t)(qrow0 + r32) * ZLD + Z_AQ + hq * 128;
#pragma unroll
        for (int dt = 0; dt < 4; ++dt)
#pragma unroll
            for (int g4 = 0; g4 < 4; ++g4)
                *(u32x2*)(op + dt * 32 + g4 * 8 + hh * 4) = (u32x2){pk_f16(oacc[dt][g4 * 4] * inv, oacc[dt][g4 * 4 + 1] * inv), pk_f16(oacc[dt][g4 * 4 + 2] * inv, oacc[dt][g4 * 4 + 3] * inv)};
    }
    __syncthreads();
}

#define XB_TMO      128
#define XB_XCNT(j)  (256  + 64 * (j))
#define XB_XSUB(j)  (1280 + 64 * (j))
#define XB_XGEN(j)  (2304 + 64 * (j))
#define XB_TOP      3328
#define XB_TOPGEN   3392
#define XCD_BAR_WORDS 3456
#define XB_SPIN_CAP (1u << 18)

__device__ __forceinline__ unsigned xb_ld(unsigned* p)              { return __hip_atomic_load(p, __ATOMIC_RELAXED, __HIP_MEMORY_SCOPE_AGENT); }
__device__ __forceinline__ unsigned xb_add(unsigned* p, unsigned v) { return __hip_atomic_fetch_add(p, v, __ATOMIC_RELAXED, __HIP_MEMORY_SCOPE_AGENT); }
__device__ __forceinline__ unsigned xb_xcc_id() { return (unsigned)__builtin_amdgcn_s_getreg((3 << 11) | 20) & 0xFu; }
#define XB_SPIN(cond, bar) do { unsigned _sp = 0; while (cond) { __builtin_amdgcn_s_sleep(1); \
    if ((++_sp & 255u) == 0u) { if (xb_ld(&(bar)[XB_TMO])) break; if (_sp > XB_SPIN_CAP) { atomicAdd(&(bar)[XB_TMO], 1u); break; } } } } while (0)

struct XcdBarrier {
    unsigned* bar; unsigned x;
    volatile LAS unsigned* st;
};

__device__ __forceinline__ XcdBarrier xcd_barrier_post(unsigned* bar, volatile LAS unsigned* st) {
    XcdBarrier b; b.bar = bar; b.x = xb_xcc_id(); b.st = st;
    if (threadIdx.x == 0) (void)xb_add(&bar[XB_XCNT(b.x)], 1u);
    return b;
}
__device__ __forceinline__ void xcd_barrier_complete(unsigned* bar, unsigned x, unsigned& nloc, unsigned& nx) {
    const unsigned G = gridDim.x * gridDim.y * gridDim.z;
    unsigned sum, cnt, mine, sp = 0u;
    for (;;) {
        sum = 0u; cnt = 0u; mine = 0u;
#pragma unroll
        for (unsigned j = 0; j < 16; ++j) { const unsigned c = xb_ld(&bar[XB_XCNT(j)]); sum += c; cnt += (c > 0u) ? 1u : 0u; mine = (j == x) ? c : mine; }
        if (sum == G) break;
        __builtin_amdgcn_s_sleep(1);
        if ((++sp & 255u) == 0u) { if (xb_ld(&bar[XB_TMO])) break; if (sp > XB_SPIN_CAP) { atomicAdd(&bar[XB_TMO], 1u); break; } }
    }
    nloc = mine > 0u ? mine : 1u; nx = cnt > 0u ? cnt : 1u;
}

__device__ __forceinline__ void xcd_barrier(const XcdBarrier& b) {
    asm volatile("s_waitcnt vmcnt(0)" ::: "memory");
    __syncthreads();
    if (threadIdx.x == 0) {
        unsigned* bar = b.bar;
        __builtin_amdgcn_s_waitcnt(0);
        unsigned nloc = b.st[0], nx = b.st[1];
        if (nloc == 0u) { xcd_barrier_complete(bar, b.x, nloc, nx); b.st[0] = nloc; b.st[1] = nx; }
        const unsigned old = xb_add(&bar[XB_XSUB(b.x)], 1u);
        const unsigned gen = old / nloc;
        if (old + 1u == (gen + 1u) * nloc) {
            __builtin_amdgcn_fence(__ATOMIC_RELEASE, "agent");
            asm volatile("s_waitcnt vmcnt(0)" ::: "memory");
            const unsigned og = xb_add(&bar[XB_TOP], 1u);
            const unsigned tg = og / nx;
            if (og + 1u == (tg + 1u) * nx) xb_add(&bar[XB_TOPGEN], 1u);
            else XB_SPIN(xb_ld(&bar[XB_TOPGEN]) == tg, bar);
            __builtin_amdgcn_fence(__ATOMIC_ACQUIRE, "agent");
            xb_add(&bar[XB_XGEN(b.x)], 1u);
            asm volatile("s_waitcnt vmcnt(0)" ::: "memory");
        } else {
            XB_SPIN(xb_ld(&bar[XB_XGEN(b.x)]) == gen, bar);
            __builtin_amdgcn_fence(__ATOMIC_ACQUIRE, "agent");
            asm volatile("s_waitcnt vmcnt(0)" ::: "memory");
        }
    }
    __syncthreads();
}


#define gsync(bar_, epoch_) xcd_barrier(xbar)
__device__ __forceinline__ void sub_barrier(unsigned* word, unsigned target) {
    asm volatile("s_waitcnt vmcnt(0) lgkmcnt(0)" ::: "memory");
    __syncthreads();
    if (threadIdx.x == 0) {
        __builtin_amdgcn_fence(__ATOMIC_RELEASE, "agent");
        asm volatile("s_waitcnt vmcnt(0)" ::: "memory");
        (void)__hip_atomic_fetch_add(word, 1u, __ATOMIC_RELAXED, __HIP_MEMORY_SCOPE_AGENT);
        unsigned sp = 0;
        while (__hip_atomic_load(word, __ATOMIC_RELAXED, __HIP_MEMORY_SCOPE_AGENT) < target) { __builtin_amdgcn_s_sleep(2); if (++sp > (1u << 22)) break; }
        __builtin_amdgcn_fence(__ATOMIC_ACQUIRE, "agent");
        asm volatile("s_waitcnt vmcnt(0)" ::: "memory");
    }
    __syncthreads();
}
__device__ __forceinline__ void sub_wait(unsigned* word, unsigned target) {
    if (threadIdx.x == 0) {
        unsigned sp = 0;
        while (__hip_atomic_load(word, __ATOMIC_RELAXED, __HIP_MEMORY_SCOPE_AGENT) < target) { __builtin_amdgcn_s_sleep(2); if (++sp > (1u << 22)) break; }
        __builtin_amdgcn_fence(__ATOMIC_ACQUIRE, "agent");
        asm volatile("s_waitcnt vmcnt(0)" ::: "memory");
    }
    __syncthreads();
}
typedef const __attribute__((address_space(4))) Params* KParamsPtr;
__device__ __forceinline__ Frame mkframe(LAS unsigned char* lds) {
    KParamsPtr kp = (KParamsPtr)__builtin_amdgcn_kernarg_segment_ptr();
    asm volatile("" : "+s"(kp));
    Frame F;
    int tid_ = threadIdx.x, bid_ = blockIdx.x, g_ = gridDim.x;
    asm volatile("" : "+v"(tid_), "+s"(bid_), "+s"(g_));
    F.lds = lds; F.tid = tid_; F.lane = F.tid & 63; F.wave = __builtin_amdgcn_readfirstlane(F.tid >> 6); F.G = g_; F.bid = bid_;
#pragma unroll
    for (int i = 0; i < 23; ++i) F.in[i] = kp->in[i];
    F.out = kp->out; unsigned char* ws = kp->ws; F.ws = ws;
    F.MOD = (float*)(ws + WS_MOD); F.ROPE = (float*)(ws + WS_ROPE); F.W13T = (f16*)(ws + WS_WA); F.W2T = (f16*)(ws + WS_WA + WA_W2);
    F.WINT = (f16*)(ws + WS_WB); F.WBAT = (f16*)(ws + WS_WB + WB_BA); F.WBGT = (f16*)(ws + WS_WB + WB_BG); F.WOUTT = (f16*)(ws + WS_WB + WB_OUT);
    F.XH = (f16*)(ws + WS_XH); F.H16 = (f16*)(ws + WS_H16); F.OB = (f16*)(ws + WS_OB); F.GLR = (float*)(ws + WS_GLR); F.Z = (f16*)(ws + WS_Z);
    return F;
}
#ifndef PMASK
#define PMASK 0xffff
#endif
#ifndef MIX_TEST
#define MIX_TEST 0
#endif
#ifndef STOP_AT
#define STOP_AT 99
#endif
__global__ void __launch_bounds__(NTHR, 2) mega(Params p) {
    extern __shared__ __attribute__((aligned(16))) unsigned char smem[];
    cg::grid_group grid = cg::this_grid();
    LAS unsigned char* lds = (LAS unsigned char*)smem;
    volatile LAS unsigned* xst = (volatile LAS unsigned*)(lds + LDS_BYTES - 16);
    if (threadIdx.x < 4) xst[threadIdx.x] = 0u;
    __syncthreads();
    const XcdBarrier xbar = xcd_barrier_post((unsigned*)(p.ws + WS_BAR), xst);
    grid.sync();
    if (PMASK & 1) { const Frame F = mkframe(lds); phase_mod(F); }
    gsync(bar, epoch);
    for (int l = 0; l < DEPTH; ++l) {
        const bool last = (l == DEPTH - 1);
        const int mrows = last ? TL : TT;
        if (PMASK & 2) { const Frame F = mkframe(lds);
            conv_weight(F, F.in[7] + (size_t)l * DM * 2 * DFF, F.W13T, DM, 2 * DFF, 2 * DFF, 1, F.bid, F.G);
            conv_weight(F, F.in[8] + (size_t)l * DFF * DM, F.W2T, DFF, DM, DM, 3, F.bid, F.G);
            phase_norm(F, F.in[0], F.in[2], (l == 0) ? (const f16*)nullptr : F.XH, l, 0, (l == 0) ? 0 : TL, TT, F.bid, F.G); }
        gsync(bar, epoch);
        if (PMASK & 4) { const Frame F = mkframe(lds); pg8::StaticOrder S; Gemm g{F.H16, F.W13T, TT, 2 * DFF, DM, DM, DM}; S.init(g.M, g.N, F.G, F.bid); EpiSwiglu E{F.Z}; pg8::gemm_phase(F.lds, g, S, E); }
        gsync(bar, epoch);
        if (PMASK & 8) { const Frame F = mkframe(lds); pg8::StaticOrder S; Gemm g{F.Z, F.W2T, TT, DM, DFF, DFF, DFF}; S.init_tail(TL, g.M, g.N, F.G, F.bid);
            EpiResid E{F.in[0], F.in[2], F.XH, F.out, F.MOD + (size_t)l * 9 * NMOD + 2 * DM, 0.5f, l == 0, false};
            unsigned* aw = (unsigned*)(F.ws + WS_BAR + 15360 + 64 * (2 * l)); pg8::gemm_phase(F.lds, g, S, E, aw, 2);
            const int extra = (TL / 256) * 4 + ((TT - TL) / 128) * 4 - 2 * F.G;
            if (extra >= 0 && extra < F.G && F.bid >= extra) { const int ci = F.bid - extra, nc = F.G - extra;
                conv_weight(F, F.in[11] + (size_t)l * DM * INC, F.WINT, DM, INC, NIN, 2, ci, nc);
                conv_weight(F, F.in[20] + (size_t)l * DM * DM, F.WBAT, DM, DM, DM, 0, ci, nc);
                conv_weight(F, F.in[21] + (size_t)l * DM * DM, F.WBGT, DM, DM, DM, 0, ci, nc);
                conv_weight(F, F.in[22] + (size_t)l * DM * DM, F.WOUTT, DM, DM, DM, 3, ci, nc);
                sub_wait(aw, (unsigned)F.G);
                phase_norm(F, F.in[0], F.in[2], F.XH, l, 1, 0, TL, ci, nc); }
            else if (!(extra >= 0 && extra < F.G)) {
                conv_weight(F, F.in[11] + (size_t)l * DM * INC, F.WINT, DM, INC, NIN, 2, F.bid, F.G);
                conv_weight(F, F.in[20] + (size_t)l * DM * DM, F.WBAT, DM, DM, DM, 0, F.bid, F.G);
                conv_weight(F, F.in[21] + (size_t)l * DM * DM, F.WBGT, DM, DM, DM, 0, F.bid, F.G);
                conv_weight(F, F.in[22] + (size_t)l * DM * DM, F.WOUTT, DM, DM, DM, 3, F.bid, F.G);
                sub_wait(aw, (unsigned)F.G); phase_norm(F, F.in[0], F.in[2], F.XH, l, 1, 0, TL, F.bid, F.G); } }
        gsync(bar, epoch);
        if (STOP_AT == 3) return;
        if (PMASK & 2) { const Frame F = mkframe(lds);
            phase_norm(F, F.in[0], F.in[2], F.XH, l, 1, TL, TT, F.bid, F.G); }
        gsync(bar, epoch);
        if (PMASK & 16) { const Frame F = mkframe(lds); pg8::StaticOrder S; Gemm g{F.H16, F.WINT, TT, NIN, DM, DM, DM}; S.init(g.M, g.N, F.G, F.bid); EpiWin E{F.Z, F.GLR}; pg8::gemm_phase(F.lds, g, S, E); }
        gsync(bar, epoch);
        { const Frame F = mkframe(lds); const int sub = (F.bid & 7) + 8 * (F.bid >> 4), half = F.G >> 1;
          if (((F.bid >> 3) & 1) == 0) phase_gla(F, l, sub, half);
          else { phase_qkprep(F, l, last, sub, half); sub_barrier((unsigned*)(F.ws + WS_BAR + 14336 + 256 * l), (unsigned)half); phase_attn(F, l, last, sub, half); } }
        gsync(bar, epoch);
        { const Frame F = mkframe(lds); phase_glacomb(F, l, mrows); }
        gsync(bar, epoch);
        if ((PMASK & 512) && MIX_TEST != 2) { const Frame F = mkframe(lds); pg8::StaticOrder S; Gemm g{F.Z + Z_AQ, F.WBAT, mrows, DM, DM, ZLD, DM}; S.init_tail(TL, g.M, g.N, F.G, F.bid); EpiMerge<false> E{F.H16, F.Z + Z_GA}; pg8::gemm_phase(F.lds, g, S, E); }
        if ((PMASK & 512) && MIX_TEST != 1) { const Frame F = mkframe(lds); pg8::StaticOrder S; Gemm g{F.Z + Z_GR, F.WBGT, mrows, DM, DM, ZLD, DM}; S.init_tail(TL, g.M, g.N, F.G, F.bid); EpiMerge<(MIX_TEST != 2)> E{F.H16, F.Z + Z_GG}; pg8::gemm_phase(F.lds, g, S, E); }
        gsync(bar, epoch);
        if (PMASK & 1024) { const Frame F = mkframe(lds); pg8::StaticOrder S; Gemm g{F.H16, F.WOUTT, mrows, DM, DM, DM, DM}; S.init_tail(TL, g.M, g.N, F.G, F.bid);
            EpiResid E{F.in[0], F.in[2], F.XH, F.out, F.MOD + (size_t)l * 9 * NMOD + 5 * DM, 1.0f, false, false}; pg8::gemm_phase(F.lds, g, S, E);
            int extra = (TL / 256) * 4 + ((mrows - TL) / 128) * 4 - 2 * F.G; if (extra < 0 || extra >= F.G) extra = 0;
            if (F.bid >= extra) { const int ci = F.bid - extra, nc = F.G - extra;
                conv_weight(F, F.in[9] + (size_t)l * DM * 2 * DFF, F.W13T, DM, 2 * DFF, 2 * DFF, 1, ci, nc);
                conv_weight(F, F.in[10] + (size_t)l * DFF * DM, F.W2T, DFF, DM, DM, 3, ci, nc); } }
        gsync(bar, epoch);
        if (STOP_AT == 9) return;
        if (PMASK & 2) { const Frame F = mkframe(lds);
            phase_norm(F, F.in[0], F.in[2], F.XH, l, 2, 0, mrows, F.bid, F.G); }
        gsync(bar, epoch);
        if (PMASK & 4) { const Frame F = mkframe(lds); pg8::StaticOrder S; Gemm g{F.H16, F.W13T, mrows, 2 * DFF, DM, DM, DM}; S.init(g.M, g.N, F.G, F.bid); EpiSwiglu E{F.Z}; pg8::gemm_phase(F.lds, g, S, E); }
        gsync(bar, epoch);
        if (PMASK & 8) { const Frame F = mkframe(lds); pg8::StaticOrder S; Gemm g{F.Z, F.W2T, mrows, DM, DFF, DFF, DFF}; S.init_tail(TL, g.M, g.N, F.G, F.bid);
            EpiResid E{F.in[0], F.in[2], F.XH, F.out, F.MOD + (size_t)l * 9 * NMOD + 8 * DM, 0.5f, false, last};
            unsigned* aw = (unsigned*)(F.ws + WS_BAR + 15360 + 64 * (2 * l + 1)); pg8::gemm_phase(F.lds, g, S, E, last ? (unsigned*)nullptr : aw, 2);
            if (!last) { int extra = (TL / 256) * 4 + ((mrows - TL) / 128) * 4 - 2 * F.G; if (extra < 0 || extra >= F.G) extra = 0;
                if (F.bid >= extra) { sub_wait(aw, (unsigned)F.G); phase_norm(F, F.in[0], F.in[2], F.XH, l + 1, 0, 0, TL, F.bid - extra, F.G - extra); } } }
        gsync(bar, epoch);
    }
}

extern "C" void kernel_launch(void* const* d_in, const int* in_sizes, int n_in, void* d_out, int out_size, void* d_ws, size_t ws_size, hipStream_t stream) {
    static int grid = 0;
    if (grid == 0) {
        if (n_in != 23 || ws_size < WS_END) { fprintf(stderr, "kernel_launch: need 23 inputs and %zu bytes of workspace (got %d, %zu)\n", (size_t)WS_END, n_in, ws_size); grid = -1; return; }
        int dev = 0, cus = 0, per_cu = 0;
        hipGetDevice(&dev); hipDeviceGetAttribute(&cus, hipDeviceAttributeMultiprocessorCount, dev);
        if (hipFuncSetAttribute((const void*)mega, hipFuncAttributeMaxDynamicSharedMemorySize, LDS_BYTES) != hipSuccess) { fprintf(stderr, "kernel_launch: hipFuncSetAttribute failed\n"); grid = -1; return; }
        if (hipOccupancyMaxActiveBlocksPerMultiprocessor(&per_cu, (const void*)mega, NTHR, LDS_BYTES) != hipSuccess || per_cu < 1) { fprintf(stderr, "kernel_launch: occupancy query says %d\n", per_cu); per_cu = 1; }
        (void)hipGetLastError();
        grid = cus;
    }
    if (grid < 0) return;
    if (hipMemsetAsync((char*)d_ws + WS_BAR, 0, 16384, stream) != hipSuccess) { fprintf(stderr, "kernel_launch: memset failed\n"); return; }
    Params p{};
    for (int i = 0; i < 23; ++i) p.in[i] = (const float*)d_in[i];
    p.out = (float*)d_out; p.ws = (unsigned char*)d_ws;
    void* args[] = {&p};
    hipError_t e = hipLaunchCooperativeKernel((const void*)mega, dim3(grid), dim3(NTHR), args, LDS_BYTES, stream);
    if (e != hipSuccess) fprintf(stderr, "kernel_launch: cooperative launch failed: %s (grid %d)\n", hipGetErrorString(e), grid);
}
```
